# Optimizing an MI355X kernel written in HIP

```python
import jax, jax.numpy as jnp
from jax import lax
import numpy as np

D_MODEL = 1024
BATCH = 16
SEQ = 2048
DEPTH = 1

RET_HEADS = 4
RET_DK = 256
RET_DV = 512
RET_QK_W = RET_HEADS * RET_DK
RET_V_W = RET_HEADS * RET_DV
RET_CHUNK = 128
ROPE_BASE = 10000.0
POOL_WINDOWS = (2, 4, 8, 16)
POOL_GROUPS = 4
POOL_GROUP_W = 256
POOL_W = POOL_GROUPS * POOL_GROUP_W
IN_SIZES = (RET_QK_W, RET_QK_W, RET_V_W, RET_V_W, POOL_W, D_MODEL, D_MODEL)
IN_W = sum(IN_SIZES)
D_FF = 2816
N_MOD = 9
EPS = 1e-6

kernel_name = "hybrid_retention_pool_macaron_adaln"


def rms_norm(x, w):
    xf = x.astype(jnp.float32)
    y = xf * lax.rsqrt(jnp.mean(xf * xf, axis=-1, keepdims=True) + EPS)
    return (y * w.astype(jnp.float32)).astype(x.dtype)


def modulate(h, shift, scale):
    return h * (1 + scale[:, None, :]) + shift[:, None, :]


def swiglu(h, w13, w2):
    a, b = jnp.split(h @ w13, 2, axis=-1)
    return (jax.nn.silu(a) * b) @ w2


def rope(x):
    S, D = x.shape[1], x.shape[-1]
    half = D // 2
    inv = 1.0 / (ROPE_BASE ** (jnp.arange(half, dtype=jnp.float32) / half))
    ang = jnp.arange(S, dtype=jnp.float32)[:, None] * inv[None, :]
    cos = jnp.cos(ang)[None, :, None, :]
    sin = jnp.sin(ang)[None, :, None, :]
    x1, x2 = x[..., :half], x[..., half:]
    return jnp.concatenate([x1 * cos - x2 * sin, x1 * sin + x2 * cos], axis=-1)


def retention_chunkwise(q, k, v):
    B, S, H, DK = q.shape
    DV = v.shape[-1]
    C = RET_CHUNK
    N = S // C
    log_gamma = jnp.log1p(-(2.0 ** (-5.0 - jnp.arange(H, dtype=jnp.float32))))
    idx = jnp.arange(C, dtype=jnp.float32)
    diff = idx[:, None] - idx[None, :]
    inner_decay = jnp.where(diff >= 0, jnp.exp(log_gamma[:, None, None] * jnp.maximum(diff, 0.0)), 0.0)
    q_decay = jnp.exp(log_gamma[:, None] * (idx + 1.0))[None, :, :, None]
    k_decay = jnp.exp(log_gamma[:, None] * (C - 1.0 - idx))[None, :, :, None]
    chunk_decay = jnp.exp(log_gamma * C)[None, :, None, None]

    def to_chunks(t):
        return t.reshape(B, N, C, H, t.shape[-1]).transpose(1, 0, 3, 2, 4)

    qc, kc, vc = to_chunks(q), to_chunks(k), to_chunks(v)

    def step(state, xs):
        qi, ki, vi = xs
        scores = jnp.einsum('bhid,bhjd->bhij', qi, ki) * inner_decay
        inner = jnp.einsum('bhij,bhje->bhie', scores, vi)
        cross = jnp.einsum('bhid,bhde->bhie', qi * q_decay, state)
        new_state = chunk_decay * state + jnp.einsum('bhjd,bhje->bhde', ki * k_decay, vi)
        return new_state, inner + cross

    state0 = jnp.zeros((B, H, DK, DV), jnp.float32)
    _, out = lax.scan(step, state0, (qc, kc, vc))
    return out.transpose(1, 0, 3, 2, 4).reshape(B, S, H, DV)


def head_group_norm(y, w):
    B, S, H, DV = y.shape
    mu = jnp.mean(y, axis=-1, keepdims=True)
    yc = y - mu
    var = jnp.mean(yc * yc, axis=-1, keepdims=True)
    return (yc * lax.rsqrt(var + EPS)).reshape(B, S, H * DV) * w.astype(jnp.float32)


def causal_multiscale_pool(u, lin_w, scale):
    B, S, _ = u.shape
    uf = u.astype(jnp.float32).reshape(B, S, POOL_GROUPS, POOL_GROUP_W)
    cs = jnp.cumsum(uf, axis=1)
    count = jnp.arange(1, S + 1, dtype=jnp.float32)
    outs = []
    for g, w in enumerate(POOL_WINDOWS):
        csg = cs[:, :, g]
        lagged = jnp.pad(csg[:, :S - w], ((0, 0), (w, 0), (0, 0)))
        mean = (csg - lagged) / jnp.minimum(count, float(w))[None, :, None]
        outs.append(mean - uf[:, :, g])
    pooled = jnp.stack(outs, axis=2)
    mixed = jnp.einsum('bsgc,gcd->bsgd', pooled, lin_w.astype(jnp.float32))
    return (mixed.reshape(B, S, POOL_W) * scale.astype(jnp.float32)).astype(u.dtype)


def setup_inputs(seed: int = 0) -> dict:
    key = jax.random.key(seed)
    ks = jax.random.split(key, 20)
    f = jnp.float32

    def nrm(k, shape, s):
        return jax.random.normal(k, shape, f) * s

    L, D = DEPTH, D_MODEL
    return {
        "x": nrm(ks[0], (BATCH, SEQ, D), 1.0),
        "c": nrm(ks[1], (BATCH, D), 1.0),
        "ada_w": nrm(ks[2], (L, D, N_MOD * D), 0.5 * D ** -0.5),
        "ada_b": nrm(ks[3], (L, N_MOD * D), 0.01),
        "norm_ffn1": 1.0 + nrm(ks[4], (L, D), 0.02),
        "ffn1_w13": nrm(ks[5], (L, D, 2 * D_FF), D ** -0.5),
        "ffn1_w2": nrm(ks[6], (L, D_FF, D), D_FF ** -0.5),
        "norm_mix": 1.0 + nrm(ks[7], (L, D), 0.02),
        "w_in": nrm(ks[8], (L, D, IN_W), D ** -0.5),
        "ret_gn_w": 1.0 + nrm(ks[9], (L, RET_V_W), 0.02),
        "w_ret_branch": nrm(ks[10], (L, RET_V_W, D), RET_V_W ** -0.5),
        "pool_lin": nrm(ks[11], (L, POOL_GROUPS, POOL_GROUP_W, POOL_GROUP_W), POOL_GROUP_W ** -0.5),
        "pool_scale": 1.0 + nrm(ks[12], (L, POOL_W), 0.1),
        "w_pool_branch": nrm(ks[13], (L, POOL_W, D), POOL_W ** -0.5),
        "w_out": nrm(ks[14], (L, D, D), D ** -0.5),
        "norm_ffn2": 1.0 + nrm(ks[15], (L, D), 0.02),
        "ffn2_w13": nrm(ks[16], (L, D, 2 * D_FF), D ** -0.5),
        "ffn2_w2": nrm(ks[17], (L, D_FF, D), D_FF ** -0.5),
        "norm_final": 1.0 + nrm(ks[18], (D,), 0.02),
    }


def reference(x, c, ada_w, ada_b, norm_ffn1, ffn1_w13, ffn1_w2, norm_mix, w_in, ret_gn_w,
              w_ret_branch, pool_lin, pool_scale, w_pool_branch, w_out, norm_ffn2, ffn2_w13,
              ffn2_w2, norm_final):
    B, S, D = x.shape
    c_act = jax.nn.silu(c)
    split_pts = np.cumsum(IN_SIZES)[:-1].tolist()
    for l in range(DEPTH):
        mod = c_act @ ada_w[l] + ada_b[l]
        (sh1, sc1, g1, sh2, sc2, g2, sh3, sc3, g3) = jnp.split(mod, N_MOD, axis=-1)

        h = modulate(rms_norm(x, norm_ffn1[l]), sh1, sc1)
        x = x + g1[:, None, :] * (0.5 * swiglu(h, ffn1_w13[l], ffn1_w2[l]))

        h = modulate(rms_norm(x, norm_mix[l]), sh2, sc2)
        proj = h @ w_in[l]
        q, k, v, g, u, a_r, a_p = jnp.split(proj, split_pts, axis=-1)

        qh = rope(q.reshape(B, S, RET_HEADS, RET_DK).astype(jnp.float32))
        kh = rope(k.reshape(B, S, RET_HEADS, RET_DK).astype(jnp.float32)) * (RET_DK ** -0.5)
        vh = v.reshape(B, S, RET_HEADS, RET_DV).astype(jnp.float32)
        ret = head_group_norm(retention_chunkwise(qh, kh, vh), ret_gn_w[l]).astype(x.dtype)
        y_r = (jax.nn.silu(g) * ret) @ w_ret_branch[l]

        y_p = causal_multiscale_pool(u, pool_lin[l], pool_scale[l]) @ w_pool_branch[l]

        merged = jax.nn.sigmoid(a_r) * y_r + jax.nn.sigmoid(a_p) * y_p
        x = x + g2[:, None, :] * (merged @ w_out[l])

        h = modulate(rms_norm(x, norm_ffn2[l]), sh3, sc3)
        x = x + g3[:, None, :] * (0.5 * swiglu(h, ffn2_w13[l], ffn2_w2[l]))
    return rms_norm(x, norm_final)
```

```cpp
#include <hip/hip_runtime.h>
#include <cstdio>
#include <cstdint>

#define LAS __attribute__((address_space(3)))
#define GAS __attribute__((address_space(1)))
typedef unsigned short bf16;
typedef short bf16x8 __attribute__((ext_vector_type(8)));
typedef short s16x4 __attribute__((ext_vector_type(4)));
typedef float f32x4 __attribute__((ext_vector_type(4)));
typedef float f32x2 __attribute__((ext_vector_type(2)));
typedef unsigned u32x4 __attribute__((ext_vector_type(4)));
typedef unsigned u32x2 __attribute__((ext_vector_type(2)));
typedef __bf16 bf16x2_t __attribute__((ext_vector_type(2)));

#ifndef MK_ONE_LAUNCH
#define MK_ONE_LAUNCH 1
#endif

constexpr int D = 1024, NB = 16, SEQ = 2048, M = NB * SEQ, DFF = 2816, INW = 9216;
constexpr int MH = M / 2;
constexpr float EPS = 1e-6f;
constexpr int NWAVES = 8, NTHREADS = 512;
constexpr int N_PHASES = 19;

constexpr size_t MiB = 1u << 20;
constexpr size_t WS_CTL = 0, CTL_ZERO_BYTES = 64 * 1024;
constexpr size_t WS_MODP = 1 * MiB;
constexpr size_t WS_MODF = 3 * MiB;
constexpr size_t WS_COS = 4 * MiB, WS_SIN = 5 * MiB;
constexpr size_t WS_WCF = 6 * MiB;
constexpr size_t WS_STATS = 10 * MiB;
constexpr size_t WS_W13T1 = 14 * MiB, WS_W13T2 = 25 * MiB, WS_W2T1 = 36 * MiB, WS_W2T2 = 42 * MiB;
constexpr size_t WS_WINT = 48 * MiB, WS_BCAT = 66 * MiB, WS_WOUT = 72 * MiB;
constexpr size_t WS_H = 74 * MiB;
constexpr size_t WS_BIG = 138 * MiB;
constexpr size_t WS_MERGED = 426 * MiB;
constexpr size_t WS_END = 458 * MiB;
constexpr int CW_BAR = 1024;

constexpr int LDS_BYTES = 147456;
constexpr int MISC_OFF = 131072 + 320;

__device__ __forceinline__ unsigned pk2(float lo, float hi) { f32x2 v = {lo, hi}; bf16x2_t b = __builtin_convertvector(v, bf16x2_t); return __builtin_bit_cast(unsigned, b); }
__device__ __forceinline__ float bf_lo(unsigned u) { return __uint_as_float(u << 16); }
__device__ __forceinline__ float bf_hi(unsigned u) { return __uint_as_float(u & 0xffff0000u); }
__device__ __forceinline__ float sigmoidf_(float x) { return __builtin_amdgcn_rcpf(1.f + __builtin_amdgcn_exp2f(-1.4426950408889634f * x)); }
__device__ __forceinline__ float siluf_(float x) { return x * sigmoidf_(x); }
__device__ __forceinline__ float shx(float v, int mask, int lane) { return __int_as_float(__builtin_amdgcn_ds_bpermute((lane ^ mask) << 2, __float_as_int(v))); }
__device__ __forceinline__ float wave_sum(float v, int lane) {
#pragma unroll
    for (int o = 1; o < 64; o <<= 1) v += shx(v, o, lane);
    return v;
}
#define LDS_WAIT() asm volatile("s_waitcnt lgkmcnt(0)" ::: "memory")
#define VM_WAIT() asm volatile("s_waitcnt vmcnt(0)" ::: "memory")

namespace pg8 {
#define PG8_LAS __attribute__((address_space(3)))
typedef unsigned short bf16_t;
constexpr int BM = 256, BK = 64, HALF = 128, HTB = HALF * BK * 2, STAGE_BYTES = 8 * HTB, NXCD = 8, WGM = 8;

__host__ __device__ __forceinline__ int lds_byte(int r, int c) { const int st = (r >> 4) * 2 + (c >> 5), rr = r & 15, cc = c & 31, ob = rr * 64 + cc * 2; return st * 1024 + (ob ^ (((ob >> 9) & 1) << 5)); }
__host__ __device__ __forceinline__ void stage_rc(int b, int& R, int& C) { const int st = b / 1024, sb = b % 1024, swz = sb ^ (((sb >> 9) & 1) << 5); R = (st >> 1) * 16 + swz / 64; C = (st & 1) * 32 + (swz % 64) / 2; }
__host__ __device__ __forceinline__ int perm32(int rho) { const int n = rho >> 4, i = rho & 15; return 8 * (i >> 2) + 4 * n + (i & 3); }

struct Unit { int pm, pn; };
struct Gemm { const bf16_t* A; const bf16_t* Bt; int lda, ldb, K, tsplit; long adelta; };

struct StaticOrder {
    int nM, nN, nwg, G, c;
    __host__ __device__ void init(int M_, int N_, int G_, int c_) { nM = M_ / BM; nN = N_ / BM; nwg = nM * nN; G = G_; c = c_; }
    __host__ __device__ bool next(int i, Unit& u) const {
        const long L = (long)i * G + c; if (L >= nwg) return false;
        int wgid = (int)L; { const int q = nwg / NXCD, r = nwg % NXCD, xcd = wgid % NXCD, off = wgid / NXCD; wgid = (xcd < r ? xcd * (q + 1) : r * (q + 1) + (xcd - r) * q) + off; }
        const int nig = WGM * nN, gid = wgid / nig, fm = gid * WGM, gsz = (nM - fm) < WGM ? (nM - fm) : WGM;
        u.pm = fm + ((wgid % nig) % gsz); u.pn = (wgid % nig) / gsz; return true;
    }
};

template <class Epi, bool ALIGN_EPI = true>
__device__ __forceinline__ void gemm_phase(PG8_LAS unsigned char* lds, const Gemm g, const StaticOrder& S, const Epi& E, const int tid) {
    const int wid = __builtin_amdgcn_readfirstlane(tid >> 6), lane = tid & 63, wr = wid >> 2, wc = wid & 3, fr = lane & 15, fq = lane >> 4;
    const int K = g.K, nt = K / BK, tsplit = g.tsplit; const long adelta = g.adelta;
    unsigned voffA[2], voffB[2];
#pragma unroll
    for (int i = 0; i < 2; ++i) { int R, C; stage_rc(tid * 16 + i * 8192, R, C); const int Rb = Epi::PERM ? ((R & ~31) + perm32(R & 31)) : R;
        voffA[i] = (unsigned)(R * g.lda + C) * 2u; voffB[i] = (unsigned)(Rb * g.ldb + C) * 2u; }
    const size_t kstep = (size_t)(BK * 2);
    const size_t hstepA = (size_t)HALF * g.lda * 2, hstepB = (size_t)HALF * g.ldb * 2;
    const size_t tstepA = 2 * hstepA, tstepB = 2 * hstepB;
    const unsigned ldsw = (unsigned)wid * 1024u;
    const int aoff = lds_byte(wr * 64 + fr, fq * 8), boff = lds_byte(wc * 32 + fr, fq * 8);
#define PG8_SA(b, h) (((b) * 2 + (h)) * HTB)
#define PG8_SB(b, h) ((4 + (b) * 2 + (h)) * HTB)
#define PG8_STAGE(bufoff, gbase, voff) do { _Pragma("unroll") for (int _i = 0; _i < 2; ++_i) \
        __builtin_amdgcn_global_load_lds((const unsigned*)((const char*)(gbase) + (voff)[_i]), (PG8_LAS unsigned*)(lds + (bufoff) + ldsw + _i * 8192), 16, 0, 0); } while (0)
#define PG8_LDA(dst, b, h) do { _Pragma("unroll") for (int m = 0; m < 4; ++m) _Pragma("unroll") for (int k = 0; k < 2; ++k) dst[m][k] = *(const PG8_LAS bf16x8*)(lds + PG8_SA(b, h) + aoff + m * 2048 + k * 1024); } while (0)
#define PG8_LDB(dst, b, h) do { _Pragma("unroll") for (int n = 0; n < 2; ++n) _Pragma("unroll") for (int k = 0; k < 2; ++k) dst[n][k] = *(const PG8_LAS bf16x8*)(lds + PG8_SB(b, h) + boff + n * 2048 + k * 1024); } while (0)
#define PG8_MMA(ai, bj, At, Bt) do { __builtin_amdgcn_s_setprio(1); _Pragma("unroll") for (int m = 0; m < 4; ++m) _Pragma("unroll") for (int n = 0; n < 2; ++n) _Pragma("unroll") for (int k = 0; k < 2; ++k) \
        acc[ai][bj][m][n] = __builtin_amdgcn_mfma_f32_16x16x32_bf16(Bt[n][k], At[m][k], acc[ai][bj][m][n], 0, 0, 0); __builtin_amdgcn_s_setprio(0); } while (0)
#define PG8_WAIT_V(n) asm volatile("s_waitcnt vmcnt(" #n ")" ::: "memory")
#define PG8_WAIT_L(n) asm volatile("s_waitcnt lgkmcnt(" #n ")" ::: "memory")
#define PG8_BAR __builtin_amdgcn_s_barrier()
#define PG8_SCHED __builtin_amdgcn_sched_barrier(0)
#define PG8_AT(base, tt) ((base) + (size_t)(tt) * kstep + ((tt) >= tsplit ? adelta : 0))
    Unit cur, nxt; int ui = 0;
    if (!S.next(0, cur)) return;
    f32x4 acc[2][2][4][2];
#pragma unroll
    for (int a = 0; a < 2; ++a)
#pragma unroll
        for (int b = 0; b < 2; ++b)
#pragma unroll
            for (int m = 0; m < 4; ++m)
#pragma unroll
                for (int n = 0; n < 2; ++n) acc[a][b][m][n] = (f32x4){0.f, 0.f, 0.f, 0.f};
    bf16x8 At[4][2], B0[2][2], B1[2][2];
    const char* cA = (const char*)g.A + (size_t)cur.pm * tstepA; const char* cB = (const char*)g.Bt + (size_t)cur.pn * tstepB;
    PG8_STAGE(PG8_SB(0, 0), cB, voffB); PG8_STAGE(PG8_SB(0, 1), cB + hstepB, voffB); PG8_STAGE(PG8_SA(0, 0), cA, voffA); PG8_STAGE(PG8_SA(0, 1), cA + hstepA, voffA);
    if (wr == 1) PG8_BAR;
    PG8_WAIT_V(2); PG8_BAR;
    PG8_STAGE(PG8_SB(1, 0), cB + kstep, voffB); PG8_STAGE(PG8_SA(1, 0), cA + kstep, voffA); PG8_STAGE(PG8_SB(1, 1), cB + hstepB + kstep, voffB);
    PG8_WAIT_V(6); PG8_BAR;
    for (;;) {
        const bool has_next = S.next(ui + 1, nxt);
        const char* nA = has_next ? (const char*)g.A + (size_t)nxt.pm * tstepA : cA; const char* nB = has_next ? (const char*)g.Bt + (size_t)nxt.pn * tstepB : cB;
        for (int seg = 0; seg < (Epi::HAS_MID ? 2 : 1); ++seg) {
        const int t_lo = (Epi::HAS_MID && seg == 1) ? tsplit : 0, t_hi = (Epi::HAS_MID && seg == 0) ? tsplit : nt;
        if constexpr (Epi::HAS_MID) { if (seg == 1) E.mid(acc, cur, wr, wc, fr, fq); }
        for (int t = t_lo; t < t_hi; t += 2) {
            const bool last = (t == nt - 2);
            const char* a1 = PG8_AT(cA, t + 1);
            const char* a2 = last ? nA : PG8_AT(cA, t + 2); const char* b2 = last ? nB : cB + (size_t)(t + 2) * kstep;
            const char* a3 = a2 + kstep; const char* b3 = b2 + kstep;
            PG8_LDB(B0, 0, 0); PG8_LDB(B1, 0, 1); PG8_SCHED; PG8_LDA(At, 0, 0); PG8_STAGE(PG8_SA(1, 1), a1 + hstepA, voffA);
            PG8_WAIT_V(8); PG8_WAIT_L(0); PG8_BAR; PG8_MMA(0, 0, At, B0); PG8_MMA(0, 1, At, B1); PG8_BAR; PG8_SCHED;
            PG8_LDA(At, 0, 1); PG8_STAGE(PG8_SB(0, 0), b2, voffB); PG8_STAGE(PG8_SB(0, 1), b2 + hstepB, voffB); PG8_STAGE(PG8_SA(0, 0), a2, voffA);
            PG8_WAIT_V(8); PG8_WAIT_L(0); PG8_BAR; PG8_MMA(1, 0, At, B0); PG8_MMA(1, 1, At, B1); PG8_BAR; PG8_SCHED;
            PG8_LDB(B0, 1, 0); PG8_LDB(B1, 1, 1); PG8_SCHED; PG8_LDA(At, 1, 0); PG8_STAGE(PG8_SA(0, 1), a2 + hstepA, voffA);
            PG8_WAIT_V(8); PG8_WAIT_L(0); PG8_BAR; PG8_MMA(0, 0, At, B0); PG8_MMA(0, 1, At, B1); PG8_BAR; PG8_SCHED;
            PG8_LDA(At, 1, 1); PG8_STAGE(PG8_SB(1, 0), b3, voffB); PG8_STAGE(PG8_SB(1, 1), b3 + hstepB, voffB); PG8_STAGE(PG8_SA(1, 0), a3, voffA);
            PG8_WAIT_V(8); PG8_WAIT_L(0); PG8_BAR; PG8_MMA(1, 0, At, B0); PG8_MMA(1, 1, At, B1); PG8_BAR; PG8_SCHED;
        }
        }
        if constexpr (ALIGN_EPI) { if (wr == 0) PG8_BAR; }
        E(acc, cur, wr, wc, fr, fq);
        if (!has_next) break;
#pragma unroll
        for (int a = 0; a < 2; ++a)
#pragma unroll
            for (int b = 0; b < 2; ++b)
#pragma unroll
                for (int m = 0; m < 4; ++m)
#pragma unroll
                    for (int n = 0; n < 2; ++n) acc[a][b][m][n] = (f32x4){0.f, 0.f, 0.f, 0.f};
        cur = nxt; cA = nA; cB = nB; ++ui;
        if constexpr (ALIGN_EPI) { if (wr == 1) PG8_BAR; }
    }
    PG8_WAIT_V(0);
    if constexpr (!ALIGN_EPI) { if (wr == 0) PG8_BAR; }
    PG8_BAR;
#undef PG8_SA
#undef PG8_SB
#undef PG8_STAGE
#undef PG8_LDA
#undef PG8_LDB
#undef PG8_MMA
#undef PG8_WAIT_V
#undef PG8_WAIT_L
#undef PG8_BAR
#undef PG8_SCHED
#undef PG8_AT
}

typedef const f32x4 (&AccC)[2][2][4][2];
typedef f32x4 (&AccM)[2][2][4][2];

struct EpiSwiGLU {
    static constexpr bool PERM = true, HAS_MID = false;
    bf16_t* S;
    __device__ __forceinline__ void mid(AccM, const Unit&, int, int, int, int) const {}
    __device__ __forceinline__ void operator()(AccC acc, const Unit& u, int wr, int wc, int fr, int fq) const {
        const int row0 = u.pm * BM + wr * 64 + fr, col = u.pn * 128 + wc * 32 + 8 * fq;
#pragma unroll
        for (int ai = 0; ai < 2; ++ai)
#pragma unroll
            for (int m = 0; m < 4; ++m) {
                const f32x4 a0 = acc[ai][0][m][0], a1 = acc[ai][0][m][1], b0 = acc[ai][1][m][0], b1 = acc[ai][1][m][1];
                u32x4 w;
                w.x = pk2(siluf_(a0[0]) * b0[0], siluf_(a0[1]) * b0[1]); w.y = pk2(siluf_(a0[2]) * b0[2], siluf_(a0[3]) * b0[3]);
                w.z = pk2(siluf_(a1[0]) * b1[0], siluf_(a1[1]) * b1[1]); w.w = pk2(siluf_(a1[2]) * b1[2], siluf_(a1[3]) * b1[3]);
                *(u32x4*)(S + (size_t)(row0 + ai * HALF + m * 16) * DFF + col) = w;
            }
    }
};
struct EpiResid {
    static constexpr bool PERM = false, HAS_MID = false;
    const float* base; float* out; const float* gate; float scale; int row_base;
    __device__ __forceinline__ void mid(AccM, const Unit&, int, int, int, int) const {}
    __device__ __forceinline__ void operator()(AccC acc, const Unit& u, int wr, int wc, int fr, int fq) const {
        const int rt = row_base + u.pm * BM, b = rt >> 11;
        const int row0 = rt + wr * 64 + fr, col0 = u.pn * BM + wc * 32 + 4 * fq;
        const float* gp = gate + (size_t)b * INW + col0;
        f32x4 gv[2][2];
#pragma unroll
        for (int bj = 0; bj < 2; ++bj)
#pragma unroll
            for (int n = 0; n < 2; ++n) gv[bj][n] = *(const f32x4*)(gp + bj * HALF + n * 16) * scale;
#pragma unroll
        for (int ai = 0; ai < 2; ++ai)
#pragma unroll
            for (int m = 0; m < 4; ++m) { const size_t off = (size_t)(row0 + ai * HALF + m * 16) * D + col0;
#pragma unroll
                for (int bj = 0; bj < 2; ++bj)
#pragma unroll
                    for (int n = 0; n < 2; ++n) { const f32x4 bs = *(const f32x4*)(base + off + bj * HALF + n * 16); *(f32x4*)(out + off + bj * HALF + n * 16) = bs + gv[bj][n] * acc[ai][bj][m][n]; } }
    }
};
struct EpiProj {
    static constexpr bool PERM = true, HAS_MID = false;
    bf16_t* P; const float* cosT; const float* sinT; int row_base;
    __device__ __forceinline__ void mid(AccM, const Unit&, int, int, int, int) const {}
    __device__ __forceinline__ void operator()(AccC acc, const Unit& u, int wr, int wc, int fr, int fq) const {
        const int lrow0 = u.pm * BM + wr * 64 + fr, col = u.pn * BM + wc * 32 + 8 * fq, pn = u.pn;
        if (pn < 8) {
            const int d0 = wc * 32 + 8 * fq;
#pragma unroll
            for (int ai = 0; ai < 2; ++ai)
#pragma unroll
                for (int m = 0; m < 4; ++m) { const int lrow = lrow0 + ai * HALF + m * 16, pos = (row_base + lrow) & (SEQ - 1);
                    const f32x4 c0 = *(const f32x4*)(cosT + pos * 128 + d0), c1 = *(const f32x4*)(cosT + pos * 128 + d0 + 4);
                    const f32x4 s0 = *(const f32x4*)(sinT + pos * 128 + d0), s1 = *(const f32x4*)(sinT + pos * 128 + d0 + 4);
                    const f32x4 x10 = acc[ai][0][m][0], x11 = acc[ai][0][m][1], x20 = acc[ai][1][m][0], x21 = acc[ai][1][m][1];
                    const f32x4 o10 = x10 * c0 - x20 * s0, o11 = x11 * c1 - x21 * s1, o20 = x10 * s0 + x20 * c0, o21 = x11 * s1 + x21 * c1;
                    u32x4 w1, w2;
                    w1.x = pk2(o10[0], o10[1]); w1.y = pk2(o10[2], o10[3]); w1.z = pk2(o11[0], o11[1]); w1.w = pk2(o11[2], o11[3]);
                    w2.x = pk2(o20[0], o20[1]); w2.y = pk2(o20[2], o20[3]); w2.z = pk2(o21[0], o21[1]); w2.w = pk2(o21[2], o21[3]);
                    bf16_t* rp = P + (size_t)lrow * INW + col; *(u32x4*)rp = w1; *(u32x4*)(rp + HALF) = w2; }
        } else {
            const int act = (pn >= 16 && pn < 24) ? 1 : (pn >= 28 ? 2 : 0);
#pragma unroll
            for (int ai = 0; ai < 2; ++ai)
#pragma unroll
                for (int m = 0; m < 4; ++m) { bf16_t* rp = P + (size_t)(lrow0 + ai * HALF + m * 16) * INW + col;
#pragma unroll
                    for (int bj = 0; bj < 2; ++bj) { f32x4 v0 = acc[ai][bj][m][0], v1 = acc[ai][bj][m][1];
                        if (act == 1) {
#pragma unroll
                            for (int j = 0; j < 4; ++j) { v0[j] = siluf_(v0[j]); v1[j] = siluf_(v1[j]); } }
                        else if (act == 2) {
#pragma unroll
                            for (int j = 0; j < 4; ++j) { v0[j] = sigmoidf_(v0[j]); v1[j] = sigmoidf_(v1[j]); } }
                        u32x4 w; w.x = pk2(v0[0], v0[1]); w.y = pk2(v0[2], v0[3]); w.z = pk2(v1[0], v1[1]); w.w = pk2(v1[2], v1[3]);
                        *(u32x4*)(rp + bj * HALF) = w; } }
        }
    }
};
struct EpiMerged {
    static constexpr bool PERM = true, HAS_MID = true;
    const bf16_t* P; bf16_t* O;
    __device__ __forceinline__ void mid(AccM acc, const Unit& u, int wr, int wc, int fr, int fq) const {
        int lrow0 = u.pm * BM + wr * 64 + fr; const int col = u.pn * BM + wc * 32 + 8 * fq;
        asm volatile("" : "+v"(lrow0));
#pragma unroll
        for (int ai = 0; ai < 2; ++ai)
#pragma unroll
            for (int m = 0; m < 4; ++m) { const bf16_t* rp = P + (size_t)(lrow0 + ai * HALF + m * 16) * INW + col;
#pragma unroll
                for (int bj = 0; bj < 2; ++bj) { const u32x4 sr = *(const u32x4*)(rp + 7168 + bj * HALF), sp = *(const u32x4*)(rp + 8192 + bj * HALF);
#pragma unroll
                    for (int j = 0; j < 4; ++j) { const unsigned a = sr[j], b = sp[j];
                        const float r0 = bf_lo(a) * __builtin_amdgcn_rcpf(bf_lo(b)), r1 = bf_hi(a) * __builtin_amdgcn_rcpf(bf_hi(b));
                        acc[ai][bj][m][j >> 1][(j & 1) * 2] *= r0; acc[ai][bj][m][j >> 1][(j & 1) * 2 + 1] *= r1; } }
                asm volatile("" ::: "memory"); }
    }
    __device__ __forceinline__ void operator()(AccC acc, const Unit& u, int wr, int wc, int fr, int fq) const {
        const int lrow0 = u.pm * BM + wr * 64 + fr, col = u.pn * BM + wc * 32 + 8 * fq;
#pragma unroll
        for (int ai = 0; ai < 2; ++ai)
#pragma unroll
            for (int m = 0; m < 4; ++m) { const int lrow = lrow0 + ai * HALF + m * 16; const bf16_t* rp = P + (size_t)lrow * INW + col;
#pragma unroll
                for (int bj = 0; bj < 2; ++bj) { const u32x4 sp = *(const u32x4*)(rp + 8192 + bj * HALF);
                    const f32x4 v0 = acc[ai][bj][m][0], v1 = acc[ai][bj][m][1]; u32x4 w;
                    w.x = pk2(v0[0] * bf_lo(sp.x), v0[1] * bf_hi(sp.x)); w.y = pk2(v0[2] * bf_lo(sp.y), v0[3] * bf_hi(sp.y));
                    w.z = pk2(v1[0] * bf_lo(sp.z), v1[1] * bf_hi(sp.z)); w.w = pk2(v1[2] * bf_lo(sp.w), v1[3] * bf_hi(sp.w));
                    *(u32x4*)(O + (size_t)lrow * D + col + bj * HALF) = w; } }
    }
};
}

typedef GAS unsigned gu32;
#define XB_TMO      128
#define XB_XCNT(j)  (256  + 64 * (j))
#define XB_XSUB(j)  (1280 + 64 * (j))
#define XB_XGEN(j)  (2304 + 64 * (j))
#define XB_TOP      3328
#define XB_TOPGEN   3392
#define XCD_BAR_WORDS 3456
#define XB_SPIN_CAP (1u << 18)
__device__ __forceinline__ unsigned xb_ld(unsigned* p)              { return __hip_atomic_load(p, __ATOMIC_RELAXED, __HIP_MEMORY_SCOPE_AGENT); }
__device__ __forceinline__ unsigned xb_add(unsigned* p, unsigned v) { return __hip_atomic_fetch_add(p, v, __ATOMIC_RELAXED, __HIP_MEMORY_SCOPE_AGENT); }
__device__ __forceinline__ unsigned xb_xcc_id() { return (unsigned)__builtin_amdgcn_s_getreg((3 << 11) | 20) & 0xFu; }
#define XB_SPIN(cond, bar) do { unsigned _sp = 0; while (cond) { __builtin_amdgcn_s_sleep(1); \
    if ((++_sp & 255u) == 0u) { if (xb_ld(&(bar)[XB_TMO])) break; if (_sp > XB_SPIN_CAP) { atomicAdd(&(bar)[XB_TMO], 1u); break; } } } } while (0)
struct XcdBarrier { unsigned* bar; unsigned x; volatile LAS unsigned* st; };
__device__ __forceinline__ XcdBarrier xcd_barrier_post(unsigned* bar, volatile LAS unsigned* st) {
    XcdBarrier b; b.bar = bar; b.x = xb_xcc_id(); b.st = st;
    if (threadIdx.x == 0) (void)xb_add(&bar[XB_XCNT(b.x)], 1u);
    return b;
}
__device__ __forceinline__ void xcd_barrier_complete(unsigned* bar, unsigned x, unsigned& nloc, unsigned& nx) {
    const unsigned G = gridDim.x * gridDim.y * gridDim.z;
    unsigned sum, cnt, mine, sp = 0u;
    for (;;) {
        sum = 0u; cnt = 0u; mine = 0u;
#pragma unroll
        for (unsigned j = 0; j < 16; ++j) { const unsigned c = xb_ld(&bar[XB_XCNT(j)]); sum += c; cnt += (c > 0u) ? 1u : 0u; mine = (j == x) ? c : mine; }
        if (sum == G) break;
        __builtin_amdgcn_s_sleep(1);
        if ((++sp & 255u) == 0u) { if (xb_ld(&bar[XB_TMO])) break; if (sp > XB_SPIN_CAP) { atomicAdd(&bar[XB_TMO], 1u); break; } }
    }
    nloc = mine > 0u ? mine : 1u; nx = cnt > 0u ? cnt : 1u;
}
__device__ __forceinline__ void xcd_barrier(const XcdBarrier& b, const int tid) {
    asm volatile("s_waitcnt vmcnt(0)" ::: "memory");
    __syncthreads();
    if (tid == 0) {
        unsigned* bar = b.bar;
        __builtin_amdgcn_s_waitcnt(0);
        unsigned nloc = b.st[0], nx = b.st[1];
        if (nloc == 0u) { xcd_barrier_complete(bar, b.x, nloc, nx); b.st[0] = nloc; b.st[1] = nx; }
        const unsigned old = xb_add(&bar[XB_XSUB(b.x)], 1u);
        const unsigned gen = old / nloc;
        if (old + 1u == (gen + 1u) * nloc) {
            __builtin_amdgcn_fence(__ATOMIC_RELEASE, "agent");
            asm volatile("s_waitcnt vmcnt(0)" ::: "memory");
            const unsigned og = xb_add(&bar[XB_TOP], 1u);
            const unsigned tg = og / nx;
            if (og + 1u == (tg + 1u) * nx) xb_add(&bar[XB_TOPGEN], 1u);
            else XB_SPIN(xb_ld(&bar[XB_TOPGEN]) == tg, bar);
            __builtin_amdgcn_fence(__ATOMIC_ACQUIRE, "agent");
            xb_add(&bar[XB_XGEN(b.x)], 1u);
            asm volatile("s_waitcnt vmcnt(0)" ::: "memory");
        } else {
            XB_SPIN(xb_ld(&bar[XB_XGEN(b.x)]) == gen, bar);
            __builtin_amdgcn_fence(__ATOMIC_ACQUIRE, "agent");
            asm volatile("s_waitcnt vmcnt(0)" ::: "memory");
        }
    }
    __syncthreads();
}

__device__ __forceinline__ void transpose_item(const float* W, int K, int N, bf16* WT, int ldt, int koff, int mode, LAS float* scr, int item, int lane) {
    const int nblk = N / 32, kb = item / nblk, nb = item % nblk, k0 = 64 * kb, n0 = 32 * nb;
#pragma unroll 8
    for (int i = 0; i < 32; ++i) { const int kk = 2 * i + (lane >> 5); scr[kk * 33 + (lane & 31)] = W[(size_t)(k0 + kk) * N + n0 + (lane & 31)]; }
    LDS_WAIT(); asm volatile("" ::: "memory");
    int drow0 = n0; float sc = 1.f;
    if (mode == 1) { const int half = n0 / DFF, ch = n0 - half * DFF; drow0 = 256 * (ch >> 7) + 128 * half + (ch & 127); }
    if (mode == 2 && n0 >= 1024 && n0 < 2048) sc = 0.0625f;
    const int c = lane & 7;
#pragma unroll
    for (int j = 0; j < 4; ++j) { const int n = (lane >> 3) + 8 * j; const LAS float* s = scr + (8 * c) * 33 + n;
        u32x4 o; o.x = pk2(s[0 * 33] * sc, s[1 * 33] * sc); o.y = pk2(s[2 * 33] * sc, s[3 * 33] * sc); o.z = pk2(s[4 * 33] * sc, s[5 * 33] * sc); o.w = pk2(s[6 * 33] * sc, s[7 * 33] * sc);
        *(u32x4*)(WT + (size_t)(drow0 + n) * ldt + koff + k0 + 8 * c) = o; }
    LDS_WAIT(); asm volatile("" ::: "memory");
}

__device__ __forceinline__ void ada_unit(const float* c, const float* ada_w, float* modp, LAS unsigned char* lds, int au, int tid, int wave, int lane) {
    const int cg = au % 72, kh = au / 72;
    LAS float* scs = (LAS float*)lds;
    LAS float* red = (LAS float*)(lds + 32768);
    for (int idx = tid; idx < 512 * 16; idx += NTHREADS) { const int kk = idx >> 4, b = idx & 15; scs[idx] = siluf_(c[b * D + kh * 512 + kk]); }
    __syncthreads();
    f32x2 acc[16];
#pragma unroll
    for (int b = 0; b < 16; ++b) acc[b] = (f32x2){0.f, 0.f};
    const float* wp = ada_w + (size_t)(kh * 512 + wave * 64) * INW + cg * 128 + 2 * lane;
#pragma unroll 1
    for (int k8 = 0; k8 < 64; k8 += 8) {
        f32x2 w[8];
#pragma unroll
        for (int i = 0; i < 8; ++i) w[i] = *(const f32x2*)(wp + (size_t)(k8 + i) * INW);
#pragma unroll
        for (int i = 0; i < 8; ++i) { const LAS f32x4* sp = (const LAS f32x4*)(scs + (wave * 64 + k8 + i) * 16);
#pragma unroll
            for (int q = 0; q < 4; ++q) { const f32x4 s = sp[q];
                acc[4 * q + 0] += w[i] * s[0]; acc[4 * q + 1] += w[i] * s[1]; acc[4 * q + 2] += w[i] * s[2]; acc[4 * q + 3] += w[i] * s[3]; } }
    }
#pragma unroll
    for (int b = 0; b < 16; ++b) *(LAS f32x2*)(red + (wave * 16 + b) * 128 + 2 * lane) = acc[b];
    __syncthreads();
    for (int o = tid; o < 16 * 128; o += NTHREADS) { float s = 0.f;
#pragma unroll
        for (int w = 0; w < 8; ++w) s += red[w * 2048 + o];
        const int b = o >> 7, col = o & 127; modp[(size_t)kh * (16 * INW) + b * INW + cg * 128 + col] = s; }
    __syncthreads();
}

__device__ __forceinline__ void rope_entry(float* cosT, float* sinT, int idx) {
    const int pos = idx >> 7, i = idx & 127;
    double inv = 1.0, rr = 0.9305720409296989; int e = i;
#pragma unroll
    for (int s = 0; s < 7; ++s) { if (e & 1) inv *= rr; rr *= rr; e >>= 1; }
    const float ang = (float)pos * (float)inv;
    const double a = (double)ang, kq = __builtin_rint(a * 0.6366197723675814), r = __builtin_fma(-kq, 1.5707963267948966, a) - kq * 6.123233995736766e-17, r2 = r * r;
    double sp = -7.647163731819816e-13; sp = sp * r2 + 1.605904383682161e-10; sp = sp * r2 - 2.505210838544172e-08; sp = sp * r2 + 2.755731922398589e-06; sp = sp * r2 - 1.984126984126984e-04; sp = sp * r2 + 8.333333333333333e-03; sp = sp * r2 - 1.666666666666667e-01;
    const double sr = r + r * r2 * sp;
    double cp = 4.779477332387385e-14; cp = cp * r2 - 1.147074559772972e-11; cp = cp * r2 + 2.087675698786810e-09; cp = cp * r2 - 2.755731922398589e-07; cp = cp * r2 + 2.480158730158730e-05; cp = cp * r2 - 1.388888888888889e-03; cp = cp * r2 + 4.166666666666666e-02; cp = cp * r2 - 0.5;
    const double cr = 1.0 + r2 * cp;
    const int qd = ((int)kq) & 3;
    const double sv = (qd == 0) ? sr : (qd == 1) ? cr : (qd == 2) ? -sr : -cr;
    const double cv = (qd == 0) ? cr : (qd == 1) ? -sr : (qd == 2) ? -cr : sr;
    cosT[idx] = (float)cv; sinT[idx] = (float)sv;
}

__device__ __forceinline__ void wc_unit(const float* lin, const float* pscale, const float* wp, float* wcf, int wu, int lane) {
    const int gc0 = (wu >> 1) * 4, n = (wu & 1) * 512 + 8 * lane, g = gc0 >> 8;
    f32x4 acc[4][2];
#pragma unroll
    for (int r = 0; r < 4; ++r) { acc[r][0] = (f32x4){0.f, 0.f, 0.f, 0.f}; acc[r][1] = (f32x4){0.f, 0.f, 0.f, 0.f}; }
#pragma unroll 4
    for (int d = 0; d < 256; ++d) {
        const float* wrow = wp + (size_t)(256 * g + d) * D + n; const f32x4 w0 = *(const f32x4*)wrow, w1 = *(const f32x4*)(wrow + 4);
        const float ps = pscale[256 * g + d];
#pragma unroll
        for (int r = 0; r < 4; ++r) { const float a = lin[(size_t)(gc0 + r) * 256 + d] * ps; acc[r][0] += w0 * a; acc[r][1] += w1 * a; }
    }
#pragma unroll
    for (int r = 0; r < 4; ++r) { float* o = wcf + (size_t)(gc0 + r) * D + n; *(f32x4*)o = acc[r][0]; *(f32x4*)(o + 4) = acc[r][1]; }
}

__device__ __forceinline__ void norm_rows(const float* x, const float* nw, const float* modf, const float* modp, const float* ada_b, int shoff, bf16* h, int gw, int NGW, int lane) {
    for (int rb = gw; rb < M / 16; rb += NGW) {
        const int row0 = rb * 16, b = row0 >> 11;
        f32x4 A[4], Bc[4];
#pragma unroll
        for (int j = 0; j < 4; ++j) { const int col = 4 * lane + 256 * j; f32x4 sh, sc;
            if (modp) { const float* p0 = modp + (size_t)b * INW + shoff + col; const float* p1 = p0 + 16 * INW;
                sh = *(const f32x4*)p0 + *(const f32x4*)p1 + *(const f32x4*)(ada_b + shoff + col);
                sc = *(const f32x4*)(p0 + D) + *(const f32x4*)(p1 + D) + *(const f32x4*)(ada_b + shoff + D + col); }
            else { const float* p = modf + (size_t)b * INW + shoff + col; sh = *(const f32x4*)p; sc = *(const f32x4*)(p + D); }
            A[j] = *(const f32x4*)(nw + col) * (sc + 1.0f); Bc[j] = sh; }
#pragma unroll 2
        for (int r = 0; r < 16; ++r) {
            const f32x4* xr = (const f32x4*)(x + (size_t)(row0 + r) * D) + lane;
            f32x4 v[4]; float s = 0.f;
#pragma unroll
            for (int j = 0; j < 4; ++j) { v[j] = xr[64 * j]; s += (v[j].x * v[j].x + v[j].y * v[j].y) + (v[j].z * v[j].z + v[j].w * v[j].w); }
            const float rstd = 1.0f / sqrtf(wave_sum(s, lane) * (1.f / D) + EPS);
            u32x2* o8 = (u32x2*)(h + (size_t)(row0 + r) * D) + lane;
#pragma unroll
            for (int j = 0; j < 4; ++j) { const f32x4 y = v[j] * rstd * A[j] + Bc[j]; u32x2 w; w.x = pk2(y.x, y.y); w.y = pk2(y.z, y.w); o8[64 * j] = w; }
        }
    }
}
__device__ __forceinline__ void final_norm_rows(float* xo, const float* nw, int gw, int NGW, int lane) {
    f32x4 A[4];
#pragma unroll
    for (int j = 0; j < 4; ++j) A[j] = *(const f32x4*)(nw + 4 * lane + 256 * j);
    for (int row = gw; row < M; row += NGW) {
        f32x4* xr = (f32x4*)(xo + (size_t)row * D) + lane;
        f32x4 v[4]; float s = 0.f;
#pragma unroll
        for (int j = 0; j < 4; ++j) { v[j] = xr[64 * j]; s += (v[j].x * v[j].x + v[j].y * v[j].y) + (v[j].z * v[j].z + v[j].w * v[j].w); }
        const float rstd = 1.0f / sqrtf(wave_sum(s, lane) * (1.f / D) + EPS);
#pragma unroll
        for (int j = 0; j < 4; ++j) xr[64 * j] = v[j] * rstd * A[j];
    }
}

namespace ret {
constexpr int KS_STR = 544, VS_STR = 160, ST_STR = 544;
constexpr int KS_OFF = 0, VS_OFF = 128 * KS_STR, ST_OFF = VS_OFF + 128 * VS_STR, END_OFF = ST_OFF + 64 * ST_STR;
static_assert(END_OFF <= 131072, "retention LDS map");
__device__ __forceinline__ s16x4 trd(LAS unsigned char* p) { return __builtin_bit_cast(s16x4, __builtin_amdgcn_ds_read_tr16_b64_v4i16((LAS s16x4*)p)); }
__device__ __forceinline__ bf16x8 cat(s16x4 a, s16x4 b) { return (bf16x8){a[0], a[1], a[2], a[3], b[0], b[1], b[2], b[3]}; }
#define MFMA16(a, b, c) __builtin_amdgcn_mfma_f32_16x16x32_bf16((a), (b), (c), 0, 0, 0)

__device__ __forceinline__ void unit(bf16* P  , f32x2* stats, int uidx, LAS unsigned char* lds, int tid, int wave, int lane) {
    const int es = uidx & 7, bh = uidx >> 3, h = bh & 3, bl = bh >> 2;
    const int r16 = lane & 15, qq = lane >> 4, rho = (lane >> 2) & 3, p4 = lane & 3;
    const int it = (wave < 4) ? wave : 11 - wave;
    const float lg2 = __builtin_amdgcn_logf(1.0f - __builtin_amdgcn_exp2f(-5.0f - (float)h));
    bf16* rowp = P + (size_t)(bl * SEQ) * INW;
    const int qcol = h * 256, kcol = 1024 + h * 256, vcol = 2048 + h * 512 + es * 64;
    for (int i = tid; i < 64 * ST_STR / 16; i += NTHREADS) *(LAS u32x4*)(lds + ST_OFF + i * 16) = (u32x4){0u, 0u, 0u, 0u};
    f32x4 accS[2][4];
#pragma unroll
    for (int a = 0; a < 2; ++a)
#pragma unroll
        for (int e = 0; e < 4; ++e) accS[a][e] = (f32x4){0.f, 0.f, 0.f, 0.f};
    const float g128 = __builtin_amdgcn_exp2f(lg2 * 128.f), gm32 = __builtin_amdgcn_exp2f(lg2 * -32.f), gm128 = __builtin_amdgcn_exp2f(lg2 * -128.f);
    float kdl[8];
#pragma unroll
    for (int jj = 0; jj < 8; ++jj) { const int jl = (jj < 4) ? (4 * qq + jj) : (16 + 4 * qq + jj - 4); kdl[jj] = __builtin_amdgcn_exp2f(lg2 * (float)(127 - jl)); }
    const float gq = __builtin_amdgcn_exp2f(lg2 * (float)(16 * it + r16 + 1));
    u32x4 kst[8], vst[2];
    const bf16* const kbase0 = rowp + (size_t)(tid >> 5) * INW + kcol + 8 * (tid & 31);
    const bf16* const vbase0 = rowp + (size_t)(tid >> 3) * INW + vcol + 8 * (tid & 7);
    const bf16* const qbase0 = rowp + (size_t)(16 * it + r16) * INW + qcol + 8 * qq;
    const int kw_off = KS_OFF + (tid >> 5) * KS_STR + (tid & 31) * 16, vw_off = VS_OFF + (tid >> 3) * VS_STR + (tid & 7) * 16;
    auto stage_load = [&](int t0) {
        const bf16* kb = kbase0 + (size_t)t0 * INW; const bf16* vb = vbase0 + (size_t)t0 * INW;
        asm volatile("" : "+v"(kb), "+v"(vb));
#pragma unroll
        for (int i = 0; i < 8; ++i) kst[i] = *(const u32x4*)(kb + (size_t)(16 * i) * INW);
#pragma unroll
        for (int i = 0; i < 2; ++i) vst[i] = *(const u32x4*)(vb + (size_t)(64 * i) * INW);
    };
    auto stage_write = [&]() {
#pragma unroll
        for (int i = 0; i < 8; ++i) *(LAS u32x4*)(lds + kw_off + i * 16 * KS_STR) = kst[i];
#pragma unroll
        for (int i = 0; i < 2; ++i) *(LAS u32x4*)(lds + vw_off + i * 64 * VS_STR) = vst[i];
    };
    bf16x8 qf[8];
    auto q_load = [&](int t0) {
        const bf16* qb = qbase0 + (size_t)t0 * INW; asm volatile("" : "+v"(qb));
#pragma unroll
        for (int ks = 0; ks < 8; ++ks) qf[ks] = *(const bf16x8*)(qb + 32 * ks);
    };
    stage_load(0); q_load(0);
    stage_write();
    __syncthreads();
    LAS unsigned char* const ks_row = lds + KS_OFF + r16 * KS_STR + qq * 16;
    LAS unsigned char* const st_row = lds + ST_OFF + r16 * ST_STR + qq * 16;
    LAS unsigned char* const v_tr = lds + VS_OFF + (4 * qq + rho) * VS_STR + p4 * 8;
    LAS unsigned char* const k_tr = lds + KS_OFF + (4 * qq + rho) * KS_STR + (32 * wave) * 2 + p4 * 8;
#pragma unroll 1
    for (int c = 0; c < 16; ++c) {
        const int t0 = c * 128;
        if (c + 1 < 16) stage_load(t0 + 128);
        f32x4 ax[4];
#pragma unroll
        for (int et = 0; et < 4; ++et) { ax[et] = (f32x4){0.f, 0.f, 0.f, 0.f};
#pragma unroll
            for (int ks = 0; ks < 8; ++ks) { const bf16x8 a = *(const LAS bf16x8*)(st_row + et * 16 * ST_STR + ks * 64); ax[et] = MFMA16(a, qf[ks], ax[et]); }
            asm volatile("" ::: "memory"); }
        {
            float gsp = gm128;
#pragma unroll 1
            for (int s = 0; s < 4; ++s) {
                if (2 * s <= it) {
                    f32x4 s0 = (f32x4){0.f, 0.f, 0.f, 0.f}, s1 = (f32x4){0.f, 0.f, 0.f, 0.f};
#pragma unroll
                    for (int ks = 0; ks < 8; ++ks) { const bf16x8 a = *(const LAS bf16x8*)(ks_row + (2 * s) * 16 * KS_STR + ks * 64); s0 = MFMA16(a, qf[ks], s0); }
                    asm volatile("" ::: "memory");
                    if (2 * s + 1 <= it) {
#pragma unroll
                        for (int ks = 0; ks < 8; ++ks) { const bf16x8 a = *(const LAS bf16x8*)(ks_row + (2 * s + 1) * 16 * KS_STR + ks * 64); s1 = MFMA16(a, qf[ks], s1); }
                    }
                    asm volatile("" ::: "memory");
#pragma unroll
                    for (int reg = 0; reg < 4; ++reg) { s0[reg] *= kdl[reg] * gsp; s1[reg] *= kdl[4 + reg] * gsp; }
                    if (2 * s == it) {
#pragma unroll
                        for (int reg = 0; reg < 4; ++reg) s0[reg] = (4 * qq + reg <= r16) ? s0[reg] : 0.f;
                    }
                    if (2 * s + 1 == it) {
#pragma unroll
                        for (int reg = 0; reg < 4; ++reg) s1[reg] = (4 * qq + reg <= r16) ? s1[reg] : 0.f;
                    }
                    u32x4 pw; pw.x = pk2(s0[0], s0[1]); pw.y = pk2(s0[2], s0[3]); pw.z = pk2(s1[0], s1[1]); pw.w = pk2(s1[2], s1[3]);
                    const bf16x8 pf = __builtin_bit_cast(bf16x8, pw);
#pragma unroll
                    for (int et = 0; et < 4; ++et) { const s16x4 lo = trd(v_tr + s * 32 * VS_STR + et * 32), hi = trd(v_tr + s * 32 * VS_STR + 16 * VS_STR + et * 32);
                        ax[et] = MFMA16(cat(lo, hi), pf, ax[et]); }
                    asm volatile("" ::: "memory");
                }
                gsp *= gm32;
            }
        }
        if (c + 1 < 16) q_load(t0 + 128);
        {
            float s1 = 0.f, s2 = 0.f; const size_t lrow = (size_t)(bl * SEQ + t0 + 16 * it + r16);
            bf16* op = P + lrow * INW + vcol + 4 * qq;
#pragma unroll
            for (int et = 0; et < 4; ++et) { const f32x4 o = ax[et] * gq;
                s1 += (o[0] + o[1]) + (o[2] + o[3]); s2 += (o[0] * o[0] + o[1] * o[1]) + (o[2] * o[2] + o[3] * o[3]);
                u32x2 w; w.x = pk2(o[0], o[1]); w.y = pk2(o[2], o[3]); *(u32x2*)(op + 16 * et) = w; }
            s1 += shx(s1, 16, lane); s1 += shx(s1, 32, lane); s2 += shx(s2, 16, lane); s2 += shx(s2, 32, lane);
            if (qq == 0) stats[(lrow * 4 + h) * 8 + es] = (f32x2){s1, s2};
        }
        asm volatile("" ::: "memory");
#pragma unroll
        for (int a = 0; a < 2; ++a)
#pragma unroll
            for (int e = 0; e < 4; ++e) accS[a][e] *= g128;
        float gs = 1.0f;
#pragma unroll
        for (int s = 0; s < 4; ++s) {
            bf16x8 kf[2];
#pragma unroll
            for (int dkt = 0; dkt < 2; ++dkt) { const s16x4 lo = trd(k_tr + s * 32 * KS_STR + dkt * 32), hi = trd(k_tr + s * 32 * KS_STR + 16 * KS_STR + dkt * 32);
                const u32x4 raw = __builtin_bit_cast(u32x4, cat(lo, hi)); u32x4 sc;
#pragma unroll
                for (int j = 0; j < 4; ++j) sc[j] = pk2(bf_lo(raw[j]) * (kdl[2 * j] * gs), bf_hi(raw[j]) * (kdl[2 * j + 1] * gs));
                kf[dkt] = __builtin_bit_cast(bf16x8, sc); }
#pragma unroll
            for (int et = 0; et < 4; ++et) { const s16x4 lo = trd(v_tr + s * 32 * VS_STR + et * 32), hi = trd(v_tr + s * 32 * VS_STR + 16 * VS_STR + et * 32);
                const bf16x8 vf = cat(lo, hi);
                accS[0][et] = MFMA16(kf[0], vf, accS[0][et]); accS[1][et] = MFMA16(kf[1], vf, accS[1][et]); }
            asm volatile("" ::: "memory");
            gs *= gm32;
        }
        __syncthreads();
#pragma unroll
        for (int dkt = 0; dkt < 2; ++dkt)
#pragma unroll
            for (int et = 0; et < 4; ++et) { const f32x4 v = accS[dkt][et]; u32x2 w; w.x = pk2(v[0], v[1]); w.y = pk2(v[2], v[3]);
                *(LAS u32x2*)(lds + ST_OFF + (16 * et + r16) * ST_STR + (32 * wave + 16 * dkt + 4 * qq) * 2) = w; }
        if (c + 1 < 16) stage_write();
        __syncthreads();
    }
}
}

__device__ __forceinline__ void gn_rows(bf16* P, const f32x2* stats, const float* gnw, int gw, int NGW, int lane) {
    const int hh = lane >> 4;
    f32x4 wv[8];
#pragma unroll
    for (int j = 0; j < 8; ++j) wv[j] = *(const f32x4*)(gnw + 32 * lane + 4 * j);
    for (int row = gw; row < MH; row += NGW) {
        const f32x4* sp = (const f32x4*)(stats + ((size_t)row * 4 + hh) * 8);
        float s1 = 0.f, s2 = 0.f;
#pragma unroll
        for (int j = 0; j < 4; ++j) { const f32x4 t = sp[j]; s1 += t.x + t.z; s2 += t.y + t.w; }
        const float mu = s1 * (1.f / 512.f), var = fmaxf(s2 * (1.f / 512.f) - mu * mu, 0.f), rstd = 1.0f / sqrtf(var + EPS);
        bf16* rp = P + (size_t)row * INW + 32 * lane;
#pragma unroll
        for (int j = 0; j < 4; ++j) { const u32x4 raw = *(const u32x4*)(rp + 2048 + 8 * j), gg = *(const u32x4*)(rp + 4096 + 8 * j); u32x4 o;
#pragma unroll
            for (int k = 0; k < 4; ++k) { const f32x4 w4 = wv[2 * j + (k >> 1)];
                const float y0 = bf_lo(gg[k]) * (bf_lo(raw[k]) - mu) * rstd * w4[(k & 1) * 2], y1 = bf_hi(gg[k]) * (bf_hi(raw[k]) - mu) * rstd * w4[(k & 1) * 2 + 1];
                o[k] = pk2(y0, y1); }
            *(u32x4*)(rp + 4096 + 8 * j) = o; }
    }
}
__device__ __forceinline__ void pool_units(bf16* P, int gw, int NGW, int lane) {
    for (int wu = gw; wu < (MH / 16) * 2; wu += NGW) {
        const int rb = wu >> 1, col = (wu & 1) * 512 + 8 * lane, g = col >> 8, w = 2 << g;
        const int row0 = rb * 16, pos0 = row0 & (SEQ - 1);
        const bf16* up = P + (size_t)row0 * INW + 6144 + col;
        float sum[8];
#pragma unroll
        for (int k = 0; k < 8; ++k) sum[k] = 0.f;
        for (int dr = 1 - w; dr < 0; ++dr) { if (pos0 + dr >= 0) { const u32x4 v = *(const u32x4*)(up + (ptrdiff_t)dr * INW);
#pragma unroll
            for (int k = 0; k < 4; ++k) { sum[2 * k] += bf_lo(v[k]); sum[2 * k + 1] += bf_hi(v[k]); } } }
#pragma unroll 4
        for (int r = 0; r < 16; ++r) {
            const u32x4 v = *(const u32x4*)(up + (size_t)r * INW);
            const int pos = pos0 + r; const float inv = 1.0f / (float)(pos + 1 < w ? pos + 1 : w);
            u32x4 o;
#pragma unroll
            for (int k = 0; k < 4; ++k) { sum[2 * k] += bf_lo(v[k]); sum[2 * k + 1] += bf_hi(v[k]); o[k] = pk2(sum[2 * k] * inv - bf_lo(v[k]), sum[2 * k + 1] * inv - bf_hi(v[k])); }
            *(u32x4*)(P + (size_t)(row0 + r) * INW + col) = o;
            if (pos - w + 1 >= 0) { const u32x4 t = *(const u32x4*)(up + (ptrdiff_t)(r - w + 1) * INW);
#pragma unroll
                for (int k = 0; k < 4; ++k) { sum[2 * k] -= bf_lo(t[k]); sum[2 * k + 1] -= bf_hi(t[k]); } }
        }
    }
}

struct Args { const float* in[19]; float* out; unsigned char* ws; int ph_lo, ph_hi; };
__device__ __forceinline__ const float* in_ptr(const Args& a, int i) { asm volatile("" : "+s"(i)); return a.in[i]; }

__global__ void __launch_bounds__(NTHREADS, 2) mk_fwd(Args args) {
    extern __shared__ __attribute__((aligned(16))) unsigned char lds_raw[];
    LAS unsigned char* lds = (LAS unsigned char*)lds_raw;
    volatile LAS unsigned* MISC = (volatile LAS unsigned*)(lds + MISC_OFF);
    const int G = gridDim.x; const int bx = blockIdx.x;
    const int wave0 = __builtin_amdgcn_readfirstlane(threadIdx.x >> 6);
    {
        unsigned* ctl0 = (unsigned*)(args.ws + WS_CTL);
        for (int u = threadIdx.x; u < (LDS_BYTES - 131072) / 4; u += NTHREADS) ((LAS unsigned*)(lds + 131072))[u] = 0u;
        __syncthreads();
    }
    XcdBarrier bar = xcd_barrier_post((unsigned*)(args.ws + WS_CTL) + CW_BAR, MISC + 8);

#define PHASE_PREAMBLE() \
        int wave = wave0; asm volatile("" : "+s"(wave)); \
        int lane; asm volatile("v_mbcnt_lo_u32_b32 %0, -1, 0\n\tv_mbcnt_hi_u32_b32 %0, -1, %0" : "=v"(lane)); \
        const int tid = wave * 64 + lane; \
        unsigned char* ws = args.ws; asm volatile("" : "+s"(ws)); \
        const int vcu = (G % 8 == 0) ? (bx % 8) * (G / 8) + bx / 8 : bx; \
        const int gw = vcu * NWAVES + wave, NGW = G * NWAVES; \
        const float* x = in_ptr(args, 0); float* out = args.out; \
        float* modp = (float*)(ws + WS_MODP); float* modf = (float*)(ws + WS_MODF); \
        float* cosT = (float*)(ws + WS_COS); float* sinT = (float*)(ws + WS_SIN); \
        float* wcf = (float*)(ws + WS_WCF); f32x2* stats = (f32x2*)(ws + WS_STATS); \
        bf16* w13t1 = (bf16*)(ws + WS_W13T1); bf16* w13t2 = (bf16*)(ws + WS_W13T2); bf16* w2t1 = (bf16*)(ws + WS_W2T1); bf16* w2t2 = (bf16*)(ws + WS_W2T2); \
        bf16* wint = (bf16*)(ws + WS_WINT); bf16* bcat = (bf16*)(ws + WS_BCAT); bf16* woutt = (bf16*)(ws + WS_WOUT); \
        bf16* H = (bf16*)(ws + WS_H); bf16* BIG = (bf16*)(ws + WS_BIG); bf16* MERGED = (bf16*)(ws + WS_MERGED);
    if (args.ph_lo == 0) {
        PHASE_PREAMBLE()
            if (vcu < 144) ada_unit(in_ptr(args, 1), in_ptr(args, 2), modp, lds, vcu, tid, wave, lane);
            for (int idx = gw * 64 + lane; idx < SEQ * 128; idx += NGW * 64) rope_entry(cosT, sinT, idx);
            for (int wu = gw; wu < 512; wu += NGW) wc_unit(in_ptr(args, 11), in_ptr(args, 12), in_ptr(args, 13), wcf, wu, lane);
            LAS float* scr = (LAS float*)(lds + wave * 16384);
            constexpr int I13 = (D / 64) * (2 * DFF / 32), I2 = (DFF / 64) * (D / 32), IIN = (D / 64) * (INW / 32), IR = (2048 / 64) * (D / 32), IO = (D / 64) * (D / 32);
            constexpr int NITEMS = 2 * I13 + 2 * I2 + IIN + IR + IO;
            for (int it = gw; it < NITEMS; it += NGW) {
                int r = it;
                if (r < I13) { transpose_item(in_ptr(args, 5), D, 2 * DFF, w13t1, D, 0, 1, scr, r, lane); continue; } r -= I13;
                if (r < I2) { transpose_item(in_ptr(args, 6), DFF, D, w2t1, DFF, 0, 0, scr, r, lane); continue; } r -= I2;
                if (r < IIN) { transpose_item(in_ptr(args, 8), D, INW, wint, D, 0, 2, scr, r, lane); continue; } r -= IIN;
                if (r < IR) { transpose_item(in_ptr(args, 10), 2048, D, bcat, 3072, 0, 0, scr, r, lane); continue; } r -= IR;
                if (r < IO) { transpose_item(in_ptr(args, 14), D, D, woutt, D, 0, 0, scr, r, lane); continue; } r -= IO;
                if (r < I13) { transpose_item(in_ptr(args, 16), D, 2 * DFF, w13t2, D, 0, 1, scr, r, lane); continue; } r -= I13;
                transpose_item(in_ptr(args, 17), DFF, D, w2t2, DFF, 0, 0, scr, r, lane);
            }
        if (args.ph_hi > 1) xcd_barrier(bar, tid);
    }
    for (int ph = (args.ph_lo > 1 ? args.ph_lo : 1); ph < args.ph_hi; ++ph) {
        PHASE_PREAMBLE()
        if (ph == 1 || ph == 4 || ph == 15) {
            if (ph == 1) {
                for (int idx = (gw * 64 + lane) * 4; idx < 16 * INW; idx += NGW * 64 * 4)
                    *(f32x4*)(modf + idx) = *(const f32x4*)(modp + idx) + *(const f32x4*)(modp + 16 * INW + idx) + *(const f32x4*)(in_ptr(args, 3) + (idx % INW));
                LAS float* scr = (LAS float*)(lds + wave * 16384);
                for (int it = gw; it < (D / 64) * (D / 32); it += NGW) transpose_item(wcf, D, D, bcat, 3072, 2048, 0, scr, it, lane);
                norm_rows(x, in_ptr(args, 4), modf, modp, in_ptr(args, 3), 0, H, gw, NGW, lane);
            } else if (ph == 4) norm_rows(out, in_ptr(args, 7), modf, nullptr, nullptr, 3 * D, H, gw, NGW, lane);
            else norm_rows(out, in_ptr(args, 15), modf, nullptr, nullptr, 6 * D, H, gw, NGW, lane);
        } else if (ph == 2 || ph == 16) {
            pg8::Gemm g{H, ph == 2 ? w13t1 : w13t2, D, D, D, 1 << 30, 0};
            pg8::StaticOrder S; S.init(M, 2 * DFF, G, bx);
            pg8::EpiSwiGLU E{BIG};
            pg8::gemm_phase<pg8::EpiSwiGLU>(lds, g, S, E, tid);
        } else if (ph == 3 || ph == 17 || ph == 9 || ph == 14) {
            pg8::Gemm g; pg8::StaticOrder S; pg8::EpiResid E;
            if (ph == 3)       { g = pg8::Gemm{BIG, w2t1, DFF, DFF, DFF, 1 << 30, 0}; S.init(M, D, G, bx); E = pg8::EpiResid{x, out, modf + 2 * D, 0.5f, 0}; }
            else if (ph == 17) { g = pg8::Gemm{BIG, w2t2, DFF, DFF, DFF, 1 << 30, 0}; S.init(M, D, G, bx); E = pg8::EpiResid{out, out, modf + 8 * D, 0.5f, 0}; }
            else { const int hb = (ph == 14); g = pg8::Gemm{MERGED, woutt, D, D, D, 1 << 30, 0}; S.init(MH, D, G, bx); E = pg8::EpiResid{out, out, modf + 5 * D, 1.0f, hb * MH}; }
            pg8::gemm_phase<pg8::EpiResid>(lds, g, S, E, tid);
        } else if (ph == 5 || ph == 10) {
            const int hb = (ph == 10);
            pg8::Gemm g{H + (size_t)hb * MH * D, wint, D, D, D, 1 << 30, 0};
            pg8::StaticOrder S; S.init(MH, INW, G, bx);
            pg8::EpiProj E{BIG, cosT, sinT, hb * MH};
            pg8::gemm_phase<pg8::EpiProj>(lds, g, S, E, tid);
        } else if (ph == 6 || ph == 11) {
            for (int u = vcu; u < 256; u += G) ret::unit(BIG, stats, u, lds, tid, wave, lane);
        } else if (ph == 7 || ph == 12) {
            gn_rows(BIG, stats, in_ptr(args, 9), gw, NGW, lane);
            pool_units(BIG, gw, NGW, lane);
        } else if (ph == 8 || ph == 13) {
            pg8::Gemm g{BIG + 4096, bcat, INW, 3072, 3072, 32, -(long)(4096 * 2 + 32 * 128)};
            pg8::StaticOrder S; S.init(MH, D, G, bx);
            pg8::EpiMerged E{BIG, MERGED};
            pg8::gemm_phase<pg8::EpiMerged>(lds, g, S, E, tid);
        } else {
            final_norm_rows(out, in_ptr(args, 18), gw, NGW, lane);
        }
        if (ph + 1 < args.ph_hi) xcd_barrier(bar, tid);
    }
}

extern "C" void kernel_launch(void* const* d_in, const int* in_sizes, int n_in, void* d_out, int out_size, void* d_ws, size_t ws_size, hipStream_t stream) {
    static int grid = 0;
    if (grid == 0) {
        if (n_in != 19 || in_sizes[0] != M * D || out_size != M * D || ws_size < WS_END) { fprintf(stderr, "kernel_launch: unexpected shapes (n_in %d, in0 %d, out %d, ws %zu)\n", n_in, n_in > 0 ? in_sizes[0] : -1, out_size, ws_size); grid = -1; return; }
        int dev = 0, cus = 0, per_cu = 0;
        if (hipGetDevice(&dev) != hipSuccess || hipDeviceGetAttribute(&cus, hipDeviceAttributeMultiprocessorCount, dev) != hipSuccess) { grid = -1; return; }
        if (hipFuncSetAttribute((const void*)mk_fwd, hipFuncAttributeMaxDynamicSharedMemorySize, LDS_BYTES) != hipSuccess) { fprintf(stderr, "kernel_launch: hipFuncSetAttribute failed\n"); grid = -1; return; }
        if (hipOccupancyMaxActiveBlocksPerMultiprocessor(&per_cu, (const void*)mk_fwd, NTHREADS, LDS_BYTES) != hipSuccess || per_cu < 1) { fprintf(stderr, "kernel_launch: occupancy query says %d blocks per CU\n", per_cu); (void)hipGetLastError(); grid = -1; return; }
        grid = cus;
    }
    if (grid < 0) return;
    (void)hipMemsetAsync((char*)d_ws + WS_CTL, 0, CTL_ZERO_BYTES, stream);
    Args a{};
    for (int i = 0; i < 19; ++i) a.in[i] = (const float*)d_in[i];
    a.out = (float*)d_out; a.ws = (unsigned char*)d_ws;
#if MK_ONE_LAUNCH
    a.ph_lo = 0; a.ph_hi = N_PHASES;
    hipLaunchKernelGGL(mk_fwd, dim3(grid), dim3(NTHREADS), LDS_BYTES, stream, a);
#else
    for (int ph = 0; ph < N_PHASES; ++ph) { a.ph_lo = ph; a.ph_hi = ph + 1; hipLaunchKernelGGL(mk_fwd, dim3(grid), dim3(NTHREADS), LDS_BYTES, stream, a); }
#endif
}
```

```cpp
#include <hip/hip_runtime.h>
#include <cstdio>
#include <cstdint>

#define LAS __attribute__((address_space(3)))
#define GAS __attribute__((address_space(1)))
typedef unsigned short bf16;
typedef short bf16x8 __attribute__((ext_vector_type(8)));
typedef short s16x4 __attribute__((ext_vector_type(4)));
typedef float f32x4 __attribute__((ext_vector_type(4)));
typedef float f32x2 __attribute__((ext_vector_type(2)));
typedef unsigned u32x4 __attribute__((ext_vector_type(4)));
typedef unsigned u32x2 __attribute__((ext_vector_type(2)));
typedef __bf16 bf16x2_t __attribute__((ext_vector_type(2)));

#ifndef MK_ONE_LAUNCH
#define MK_ONE_LAUNCH 1
#endif
#ifndef REPEAT_PH
#define REPEAT_PH -1
#endif
#ifndef REPEAT_LEN
#define REPEAT_LEN 1
#endif
#ifndef EXTRA_BARRIERS
#define EXTRA_BARRIERS 0
#endif

constexpr int D = 1024, NB = 16, SEQ = 2048, M = NB * SEQ, DFF = 2816, INW = 9216;
constexpr int MH = M / 2;
constexpr float EPS = 1e-6f;
constexpr int NWAVES = 8, NTHREADS = 512;
constexpr int N_PHASES = 19;

constexpr size_t MiB = 1u << 20;
constexpr size_t WS_CTL = 0, CTL_ZERO_BYTES = 64 * 1024;
constexpr size_t WS_MODP = 1 * MiB;
constexpr size_t WS_MODF = 3 * MiB;
constexpr size_t WS_COS = 4 * MiB, WS_SIN = 5 * MiB;
constexpr size_t WS_WCF = 6 * MiB;
constexpr size_t WS_STATS = 10 * MiB;
constexpr size_t WS_W13T1 = 14 * MiB, WS_W13T2 = 25 * MiB, WS_W2T1 = 36 * MiB, WS_W2T2 = 42 * MiB;
constexpr size_t WS_WINT = 48 * MiB, WS_BCAT = 66 * MiB, WS_WOUT = 72 * MiB;
constexpr size_t WS_H = 74 * MiB;
constexpr size_t WS_BIG = 138 * MiB;
constexpr size_t WS_MERGED = 426 * MiB;
constexpr size_t WS_SSQ = 458 * MiB;
constexpr size_t WS_CBIN = 460 * MiB;
constexpr size_t WS_CBUP = 461 * MiB;
constexpr size_t WS_RSTD = 462 * MiB;
constexpr size_t WS_END = 463 * MiB;
constexpr int CW_BAR = 1024;

constexpr int LDS_BYTES = 147456;
constexpr int MISC_OFF = 131072 + 320;

__device__ __forceinline__ unsigned pk2(float lo, float hi) { f32x2 v = {lo, hi}; bf16x2_t b = __builtin_convertvector(v, bf16x2_t); return __builtin_bit_cast(unsigned, b); }
__device__ __forceinline__ float bf_lo(unsigned u) { return __uint_as_float(u << 16); }
__device__ __forceinline__ float bf_hi(unsigned u) { return __uint_as_float(u & 0xffff0000u); }
__device__ __forceinline__ float sigmoidf_(float x) { return __builtin_amdgcn_rcpf(1.f + __builtin_amdgcn_exp2f(-1.4426950408889634f * x)); }
__device__ __forceinline__ float siluf_(float x) { return x * sigmoidf_(x); }
__device__ __forceinline__ float shx(float v, int mask, int lane) { return __int_as_float(__builtin_amdgcn_ds_bpermute((lane ^ mask) << 2, __float_as_int(v))); }
__device__ __forceinline__ float wave_sum(float v, int lane) {
#pragma unroll
    for (int o = 1; o < 64; o <<= 1) v += shx(v, o, lane);
    return v;
}
#define LDS_WAIT() asm volatile("s_waitcnt lgkmcnt(0)" ::: "memory")
#define VM_WAIT() asm volatile("s_waitcnt vmcnt(0)" ::: "memory")

namespace pg8 {
#define PG8_LAS __attribute__((address_space(3)))
typedef unsigned short bf16_t;
constexpr int BM = 256, BK = 64, HALF = 128, HTB = HALF * BK * 2, STAGE_BYTES = 8 * HTB, NXCD = 8, WGM = 8;

__host__ __device__ __forceinline__ int lds_byte(int r, int c) { const int st = (r >> 4) * 2 + (c >> 5), rr = r & 15, cc = c & 31, ob = rr * 64 + cc * 2; return st * 1024 + (ob ^ (((ob >> 9) & 1) << 5)); }
__host__ __device__ __forceinline__ void stage_rc(int b, int& R, int& C) { const int st = b / 1024, sb = b % 1024, swz = sb ^ (((sb >> 9) & 1) << 5); R = (st >> 1) * 16 + swz / 64; C = (st & 1) * 32 + (swz % 64) / 2; }
__host__ __device__ __forceinline__ int perm32(int rho) { const int n = rho >> 4, i = rho & 15; return 8 * (i >> 2) + 4 * n + (i & 3); }

struct Unit { int pm, pn; };
struct Gemm { const bf16_t* A; const bf16_t* Bt; int lda, ldb, K, tsplit; long adelta; int noepi = 0; };

struct StaticOrder {
    int nM, nN, nwg, G, c;
    __host__ __device__ void init(int M_, int N_, int G_, int c_) { nM = M_ / BM; nN = N_ / BM; nwg = nM * nN; G = G_; c = c_; }
    __host__ __device__ bool next(int i, Unit& u) const {
        const long L = (long)i * G + c; if (L >= nwg) return false;
        int wgid = (int)L; { const int q = nwg / NXCD, r = nwg % NXCD, xcd = wgid % NXCD, off = wgid / NXCD; wgid = (xcd < r ? xcd * (q + 1) : r * (q + 1) + (xcd - r) * q) + off; }
        const int nig = WGM * nN, gid = wgid / nig, fm = gid * WGM, gsz = (nM - fm) < WGM ? (nM - fm) : WGM;
        u.pm = fm + ((wgid % nig) % gsz); u.pn = (wgid % nig) / gsz; return true;
    }
};

template <class Epi, bool ALIGN_EPI = true>
__device__ __forceinline__ void gemm_phase(PG8_LAS unsigned char* lds, const Gemm g, const StaticOrder S, const Epi E, const int tid) {
    const int wid = __builtin_amdgcn_readfirstlane(tid >> 6), lane = tid & 63, wr = wid >> 2, wc = wid & 3, fr = lane & 15, fq = lane >> 4;
    const int K = g.K, nt = K / BK, tsplit = g.tsplit; const long adelta = g.adelta;
    unsigned voffA[2], voffB[2];
#pragma unroll
    for (int i = 0; i < 2; ++i) { int R, C; stage_rc(tid * 16 + i * 8192, R, C); const int Rb = Epi::PERM ? ((R & ~31) + perm32(R & 31)) : R;
        voffA[i] = (unsigned)(R * g.lda + C) * 2u; voffB[i] = (unsigned)(Rb * g.ldb + C) * 2u; }
    const size_t kstep = (size_t)(BK * 2);
    const size_t hstepA = (size_t)HALF * g.lda * 2, hstepB = (size_t)HALF * g.ldb * 2;
    const size_t tstepA = 2 * hstepA, tstepB = 2 * hstepB;
    const unsigned ldsw = (unsigned)wid * 1024u;
    const int aoff = lds_byte(wr * 64 + fr, fq * 8), boff = lds_byte(wc * 32 + fr, fq * 8);
#define PG8_SA(b, h) (((b) * 2 + (h)) * HTB)
#define PG8_SB(b, h) ((4 + (b) * 2 + (h)) * HTB)
#define PG8_STAGE(bufoff, gbase, voff) do { _Pragma("unroll") for (int _i = 0; _i < 2; ++_i) \
        __builtin_amdgcn_global_load_lds((const unsigned*)((const char*)(gbase) + (voff)[_i]), (PG8_LAS unsigned*)(lds + (bufoff) + ldsw + _i * 8192), 16, 0, 0); } while (0)
#define PG8_LDA(dst, b, h) do { _Pragma("unroll") for (int m = 0; m < 4; ++m) _Pragma("unroll") for (int k = 0; k < 2; ++k) dst[m][k] = *(const PG8_LAS bf16x8*)(lds + PG8_SA(b, h) + aoff + m * 2048 + k * 1024); } while (0)
#define PG8_LDB(dst, b, h) do { _Pragma("unroll") for (int n = 0; n < 2; ++n) _Pragma("unroll") for (int k = 0; k < 2; ++k) dst[n][k] = *(const PG8_LAS bf16x8*)(lds + PG8_SB(b, h) + boff + n * 2048 + k * 1024); } while (0)
#define PG8_MMA(ai, bj, At, Bt) do { __builtin_amdgcn_s_setprio(1); _Pragma("unroll") for (int m = 0; m < 4; ++m) _Pragma("unroll") for (int n = 0; n < 2; ++n) _Pragma("unroll") for (int k = 0; k < 2; ++k) \
        acc[ai][bj][m][n] = __builtin_amdgcn_mfma_f32_16x16x32_bf16(Bt[n][k], At[m][k], acc[ai][bj][m][n], 0, 0, 0); __builtin_amdgcn_s_setprio(0); } while (0)
#define PG8_WAIT_V(n) asm volatile("s_waitcnt vmcnt(" #n ")" ::: "memory")
#define PG8_WAIT_L(n) asm volatile("s_waitcnt lgkmcnt(" #n ")" ::: "memory")
#define PG8_BAR __builtin_amdgcn_s_barrier()
#define PG8_SCHED __builtin_amdgcn_sched_barrier(0)
#define PG8_AT(base, tt) ((base) + (size_t)(tt) * kstep + ((tt) >= tsplit ? adelta : 0))
    Unit cur, nxt; int ui = 0;
    if (!S.next(0, cur)) return;
    f32x4 acc[2][2][4][2];
#pragma unroll
    for (int a = 0; a < 2; ++a)
#pragma unroll
        for (int b = 0; b < 2; ++b)
#pragma unroll
            for (int m = 0; m < 4; ++m)
#pragma unroll
                for (int n = 0; n < 2; ++n) acc[a][b][m][n] = (f32x4){0.f, 0.f, 0.f, 0.f};
    bf16x8 At[4][2], B0[2][2], B1[2][2];
    const char* cA = (const char*)g.A + (size_t)cur.pm * tstepA; const char* cB = (const char*)g.Bt + (size_t)cur.pn * tstepB;
    PG8_STAGE(PG8_SB(0, 0), cB, voffB); PG8_STAGE(PG8_SB(0, 1), cB + hstepB, voffB); PG8_STAGE(PG8_SA(0, 0), cA, voffA); PG8_STAGE(PG8_SA(0, 1), cA + hstepA, voffA);
    if (wr == 1) PG8_BAR;
    PG8_WAIT_V(2); PG8_BAR;
    PG8_STAGE(PG8_SB(1, 0), cB + kstep, voffB); PG8_STAGE(PG8_SA(1, 0), cA + kstep, voffA); PG8_STAGE(PG8_SB(1, 1), cB + hstepB + kstep, voffB);
    PG8_WAIT_V(6); PG8_BAR;
    for (;;) {
        const bool has_next = S.next(ui + 1, nxt);
        const char* nA = has_next ? (const char*)g.A + (size_t)nxt.pm * tstepA : cA; const char* nB = has_next ? (const char*)g.Bt + (size_t)nxt.pn * tstepB : cB;
        for (int seg = 0; seg < (Epi::HAS_MID ? 2 : 1); ++seg) {
        const int t_lo = (Epi::HAS_MID && seg == 1) ? tsplit : 0, t_hi = (Epi::HAS_MID && seg == 0) ? tsplit : nt;
        if constexpr (Epi::HAS_MID) { if (seg == 1) E.mid(acc, cur, wr, wc, fr, fq); }
        for (int t = t_lo; t < t_hi; t += 2) {
            const bool last = (t == nt - 2);
            const char* a1 = PG8_AT(cA, t + 1);
            const char* a2 = last ? nA : PG8_AT(cA, t + 2); const char* b2 = last ? nB : cB + (size_t)(t + 2) * kstep;
            const char* a3 = a2 + kstep; const char* b3 = b2 + kstep;
            PG8_LDB(B0, 0, 0); PG8_LDB(B1, 0, 1); PG8_SCHED; PG8_LDA(At, 0, 0); PG8_STAGE(PG8_SA(1, 1), a1 + hstepA, voffA);
            PG8_WAIT_V(8); PG8_WAIT_L(0); PG8_BAR; PG8_MMA(0, 0, At, B0); PG8_MMA(0, 1, At, B1); PG8_BAR; PG8_SCHED;
            PG8_LDA(At, 0, 1); PG8_STAGE(PG8_SB(0, 0), b2, voffB); PG8_STAGE(PG8_SB(0, 1), b2 + hstepB, voffB); PG8_STAGE(PG8_SA(0, 0), a2, voffA);
            PG8_WAIT_V(8); PG8_WAIT_L(0); PG8_BAR; PG8_MMA(1, 0, At, B0); PG8_MMA(1, 1, At, B1); PG8_BAR; PG8_SCHED;
            PG8_LDB(B0, 1, 0); PG8_LDB(B1, 1, 1); PG8_SCHED; PG8_LDA(At, 1, 0); PG8_STAGE(PG8_SA(0, 1), a2 + hstepA, voffA);
            PG8_WAIT_V(8); PG8_WAIT_L(0); PG8_BAR; PG8_MMA(0, 0, At, B0); PG8_MMA(0, 1, At, B1); PG8_BAR; PG8_SCHED;
            PG8_LDA(At, 1, 1); PG8_STAGE(PG8_SB(1, 0), b3, voffB); PG8_STAGE(PG8_SB(1, 1), b3 + hstepB, voffB); PG8_STAGE(PG8_SA(1, 0), a3, voffA);
            PG8_WAIT_V(8); PG8_WAIT_L(0); PG8_BAR; PG8_MMA(1, 0, At, B0); PG8_MMA(1, 1, At, B1); PG8_BAR; PG8_SCHED;
        }
        }
        if constexpr (ALIGN_EPI) { if (wr == 0) PG8_BAR; }
        if (!g.noepi) E(acc, cur, wr, wc, fr, fq);
        if (!has_next) break;
#pragma unroll
        for (int a = 0; a < 2; ++a)
#pragma unroll
            for (int b = 0; b < 2; ++b)
#pragma unroll
                for (int m = 0; m < 4; ++m)
#pragma unroll
                    for (int n = 0; n < 2; ++n) acc[a][b][m][n] = (f32x4){0.f, 0.f, 0.f, 0.f};
        cur = nxt; cA = nA; cB = nB; ++ui;
        if constexpr (ALIGN_EPI) { if (wr == 1) PG8_BAR; }
    }
    PG8_WAIT_V(0);
    if constexpr (!ALIGN_EPI) { if (wr == 0) PG8_BAR; }
    PG8_BAR;
#undef PG8_SA
#undef PG8_SB
#undef PG8_STAGE
#undef PG8_LDA
#undef PG8_LDB
#undef PG8_MMA
#undef PG8_WAIT_V
#undef PG8_WAIT_L
#undef PG8_BAR
#undef PG8_SCHED
#undef PG8_AT
}

typedef const f32x4 (&AccC)[2][2][4][2];
typedef f32x4 (&AccM)[2][2][4][2];

__device__ __forceinline__ float row_rstd(const float* rstd, int row) { return ((const GAS float*)rstd)[row]; }
struct EpiSwiGLU {
    static constexpr bool PERM = true, HAS_MID = false;
    bf16_t* S; const float* ssq; const float* cb;
    __device__ __forceinline__ void mid(AccM, const Unit&, int, int, int, int) const {}
    __device__ __forceinline__ void operator()(AccC acc, const Unit& u, int wr, int wc, int fr, int fq) const {
        const int row0 = u.pm * BM + wr * 64 + fr, col = u.pn * 128 + wc * 32 + 8 * fq;
        f32x4 ca0 = (f32x4){0.f, 0.f, 0.f, 0.f}, ca1 = ca0, cb0 = ca0, cb1 = ca0;
        if (ssq) { const float* cp = cb + (size_t)((u.pm * BM) >> 11) * (2 * DFF) + u.pn * BM + wc * 32 + 8 * fq;
            ca0 = *(const GAS f32x4*)cp; ca1 = *(const GAS f32x4*)(cp + 4); cb0 = *(const GAS f32x4*)(cp + HALF); cb1 = *(const GAS f32x4*)(cp + HALF + 4); }
        float rsv[8];
#pragma unroll
        for (int r = 0; r < 8; ++r) rsv[r] = ssq ? row_rstd(ssq, row0 + (r >> 2) * HALF + (r & 3) * 16) : 1.0f;
#pragma unroll
        for (int ai = 0; ai < 2; ++ai)
#pragma unroll
            for (int m = 0; m < 4; ++m) {
                const int row = row0 + ai * HALF + m * 16;
                f32x4 a0 = acc[ai][0][m][0], a1 = acc[ai][0][m][1], b0 = acc[ai][1][m][0], b1 = acc[ai][1][m][1];
                if (ssq) { const float rs = rsv[ai * 4 + m]; a0 = a0 * rs + ca0; a1 = a1 * rs + ca1; b0 = b0 * rs + cb0; b1 = b1 * rs + cb1; }
                u32x4 w;
                w.x = pk2(siluf_(a0[0]) * b0[0], siluf_(a0[1]) * b0[1]); w.y = pk2(siluf_(a0[2]) * b0[2], siluf_(a0[3]) * b0[3]);
                w.z = pk2(siluf_(a1[0]) * b1[0], siluf_(a1[1]) * b1[1]); w.w = pk2(siluf_(a1[2]) * b1[2], siluf_(a1[3]) * b1[3]);
                *(GAS u32x4*)(S + (size_t)row * DFF + col) = w;
            }
    }
};
struct EpiResid {
    static constexpr bool PERM = true, HAS_MID = false;
    const float* base; float* out; const float* gate; bf16_t* xs; const float* nw; const float* scm; float* ssq; float scale; int row_base;
    __device__ __forceinline__ void mid(AccM, const Unit&, int, int, int, int) const {}
    __device__ __forceinline__ void operator()(AccC acc, const Unit& u, int wr, int wc, int fr, int fq) const {
        const int rt = row_base + u.pm * BM, b = rt >> 11, lane = fr + 16 * fq;
        const int row0 = rt + wr * 64 + fr, col0 = u.pn * BM + wc * 32 + 8 * fq;
        const float* gp = gate + (size_t)b * INW + col0;
        f32x4 gv[2][2], cs[2][2];
#pragma unroll
        for (int bj = 0; bj < 2; ++bj)
#pragma unroll
            for (int n = 0; n < 2; ++n) { gv[bj][n] = *(const GAS f32x4*)(gp + bj * HALF + n * 4) * scale;
                if (xs) cs[bj][n] = *(const GAS f32x4*)(nw + col0 + bj * HALF + n * 4) * (*(const GAS f32x4*)(scm + (size_t)b * INW + col0 + bj * HALF + n * 4) + 1.0f); }
#pragma unroll
        for (int ai = 0; ai < 2; ++ai)
#pragma unroll
            for (int m = 0; m < 4; ++m) { const int row = row0 + ai * HALF + m * 16; const size_t off = (size_t)row * D + col0; float sq = 0.f;
#pragma unroll
                for (int bj = 0; bj < 2; ++bj) { f32x4 o[2];
#pragma unroll
                    for (int n = 0; n < 2; ++n) { const f32x4 bs = *(const GAS f32x4*)(base + off + bj * HALF + n * 4); o[n] = bs + gv[bj][n] * acc[ai][bj][m][n]; *(GAS f32x4*)(out + off + bj * HALF + n * 4) = o[n];
                        sq += (o[n][0] * o[n][0] + o[n][1] * o[n][1]) + (o[n][2] * o[n][2] + o[n][3] * o[n][3]); }
                    if (xs) { const f32x4 y0 = o[0] * cs[bj][0], y1 = o[1] * cs[bj][1]; u32x4 w; w.x = pk2(y0[0], y0[1]); w.y = pk2(y0[2], y0[3]); w.z = pk2(y1[0], y1[1]); w.w = pk2(y1[2], y1[3]);
                        *(GAS u32x4*)(xs + off + bj * HALF) = w; } }
                if (xs) { sq += shx(sq, 16, lane); sq += shx(sq, 32, lane); if (fq == 0) ((GAS float*)ssq)[(size_t)row * 16 + u.pn * 4 + wc] = sq; }
                asm volatile("" ::: "memory"); }
    }
};
struct EpiProj {
    static constexpr bool PERM = true, HAS_MID = false;
    bf16_t* P; const float* cosT; const float* sinT; int row_base; const float* ssq; const float* cb;
    __device__ __forceinline__ void mid(AccM, const Unit&, int, int, int, int) const {}
    __device__ __forceinline__ void operator()(AccM acc, const Unit& u, int wr, int wc, int fr, int fq) const {
        const int lrow0 = u.pm * BM + wr * 64 + fr, col = u.pn * BM + wc * 32 + 8 * fq, pn = u.pn;
        { const float* cp = cb + (size_t)((row_base + u.pm * BM) >> 11) * INW + col; f32x4 cv[2][2];
#pragma unroll
            for (int bj = 0; bj < 2; ++bj)
#pragma unroll
                for (int n = 0; n < 2; ++n) cv[bj][n] = *(const GAS f32x4*)(cp + bj * HALF + n * 4);
            float rsv[8];
#pragma unroll
            for (int r = 0; r < 8; ++r) rsv[r] = row_rstd(ssq, row_base + lrow0 + (r >> 2) * HALF + (r & 3) * 16);
#pragma unroll
            for (int ai = 0; ai < 2; ++ai)
#pragma unroll
                for (int m = 0; m < 4; ++m) { const float rs = rsv[ai * 4 + m];
#pragma unroll
                    for (int bj = 0; bj < 2; ++bj)
#pragma unroll
                        for (int n = 0; n < 2; ++n) acc[ai][bj][m][n] = acc[ai][bj][m][n] * rs + cv[bj][n]; } }
        if (pn < 8) {
            const int d0 = wc * 32 + 8 * fq;
#pragma unroll
            for (int ai = 0; ai < 2; ++ai)
#pragma unroll
                for (int m = 0; m < 4; ++m) { const int lrow = lrow0 + ai * HALF + m * 16, pos = (row_base + lrow) & (SEQ - 1);
                    const f32x4 c0 = *(const GAS f32x4*)(cosT + pos * 128 + d0), c1 = *(const GAS f32x4*)(cosT + pos * 128 + d0 + 4);
                    const f32x4 s0 = *(const GAS f32x4*)(sinT + pos * 128 + d0), s1 = *(const GAS f32x4*)(sinT + pos * 128 + d0 + 4);
                    const f32x4 x10 = acc[ai][0][m][0], x11 = acc[ai][0][m][1], x20 = acc[ai][1][m][0], x21 = acc[ai][1][m][1];
                    const f32x4 o10 = x10 * c0 - x20 * s0, o11 = x11 * c1 - x21 * s1, o20 = x10 * s0 + x20 * c0, o21 = x11 * s1 + x21 * c1;
                    u32x4 w1, w2;
                    w1.x = pk2(o10[0], o10[1]); w1.y = pk2(o10[2], o10[3]); w1.z = pk2(o11[0], o11[1]); w1.w = pk2(o11[2], o11[3]);
                    w2.x = pk2(o20[0], o20[1]); w2.y = pk2(o20[2], o20[3]); w2.z = pk2(o21[0], o21[1]); w2.w = pk2(o21[2], o21[3]);
                    bf16_t* rp = P + (size_t)lrow * INW + col; *(GAS u32x4*)rp = w1; *(GAS u32x4*)(rp + HALF) = w2; }
        } else {
            const int act = (pn >= 16 && pn < 24) ? 1 : (pn >= 28 ? 2 : 0);
#pragma unroll
            for (int ai = 0; ai < 2; ++ai)
#pragma unroll
                for (int m = 0; m < 4; ++m) { bf16_t* rp = P + (size_t)(lrow0 + ai * HALF + m * 16) * INW + col;
#pragma unroll
                    for (int bj = 0; bj < 2; ++bj) { f32x4 v0 = acc[ai][bj][m][0], v1 = acc[ai][bj][m][1];
                        if (act == 1) {
#pragma unroll
                            for (int j = 0; j < 4; ++j) { v0[j] = siluf_(v0[j]); v1[j] = siluf_(v1[j]); } }
                        else if (act == 2) {
#pragma unroll
                            for (int j = 0; j < 4; ++j) { v0[j] = sigmoidf_(v0[j]); v1[j] = sigmoidf_(v1[j]); } }
                        u32x4 w; w.x = pk2(v0[0], v0[1]); w.y = pk2(v0[2], v0[3]); w.z = pk2(v1[0], v1[1]); w.w = pk2(v1[2], v1[3]);
                        *(GAS u32x4*)(rp + bj * HALF) = w; } }
        }
    }
};
struct EpiMerged {
    static constexpr bool PERM = true, HAS_MID = true;
    const bf16_t* P; bf16_t* O;
    __device__ __forceinline__ void mid(AccM acc, const Unit& u, int wr, int wc, int fr, int fq) const {
        int lrow0 = u.pm * BM + wr * 64 + fr; const int col = u.pn * BM + wc * 32 + 8 * fq;
        asm volatile("" : "+v"(lrow0));
#pragma unroll
        for (int ai = 0; ai < 2; ++ai)
#pragma unroll
            for (int m = 0; m < 4; ++m) { const bf16_t* rp = P + (size_t)(lrow0 + ai * HALF + m * 16) * INW + col;
#pragma unroll
                for (int bj = 0; bj < 2; ++bj) { const u32x4 sr = *(const GAS u32x4*)(rp + 7168 + bj * HALF), sp = *(const GAS u32x4*)(rp + 8192 + bj * HALF);
#pragma unroll
                    for (int j = 0; j < 4; ++j) { const unsigned a = sr[j], b = sp[j];
                        const float r0 = bf_lo(a) * __builtin_amdgcn_rcpf(bf_lo(b)), r1 = bf_hi(a) * __builtin_amdgcn_rcpf(bf_hi(b));
                        acc[ai][bj][m][j >> 1][(j & 1) * 2] *= r0; acc[ai][bj][m][j >> 1][(j & 1) * 2 + 1] *= r1; } }
                asm volatile("" ::: "memory"); }
    }
    __device__ __forceinline__ void operator()(AccC acc, const Unit& u, int wr, int wc, int fr, int fq) const {
        const int lrow0 = u.pm * BM + wr * 64 + fr, col = u.pn * BM + wc * 32 + 8 * fq;
#pragma unroll
        for (int ai = 0; ai < 2; ++ai)
#pragma unroll
            for (int m = 0; m < 4; ++m) { const int lrow = lrow0 + ai * HALF + m * 16; const bf16_t* rp = P + (size_t)lrow * INW + col;
#pragma unroll
                for (int bj = 0; bj < 2; ++bj) { const u32x4 sp = *(const GAS u32x4*)(rp + 8192 + bj * HALF);
                    const f32x4 v0 = acc[ai][bj][m][0], v1 = acc[ai][bj][m][1]; u32x4 w;
                    w.x = pk2(v0[0] * bf_lo(sp.x), v0[1] * bf_hi(sp.x)); w.y = pk2(v0[2] * bf_lo(sp.y), v0[3] * bf_hi(sp.y));
                    w.z = pk2(v1[0] * bf_lo(sp.z), v1[1] * bf_hi(sp.z)); w.w = pk2(v1[2] * bf_lo(sp.w), v1[3] * bf_hi(sp.w));
                    *(GAS u32x4*)(O + (size_t)lrow * D + col + bj * HALF) = w; } }
    }
};
}

typedef GAS unsigned gu32;
#define XB_TMO      128
#define XB_XCNT(j)  (256  + 64 * (j))
#define XB_XSUB(j)  (1280 + 64 * (j))
#define XB_XGEN(j)  (2304 + 64 * (j))
#define XB_TOP      3328
#define XB_TOPGEN   3392
#define XCD_BAR_WORDS 3456
#define XB_SPIN_CAP (1u << 18)
__device__ __forceinline__ unsigned xb_ld(unsigned* p)              { return __hip_atomic_load(p, __ATOMIC_RELAXED, __HIP_MEMORY_SCOPE_AGENT); }
__device__ __forceinline__ unsigned xb_add(unsigned* p, unsigned v) { return __hip_atomic_fetch_add(p, v, __ATOMIC_RELAXED, __HIP_MEMORY_SCOPE_AGENT); }
__device__ __forceinline__ unsigned xb_xcc_id() { return (unsigned)__builtin_amdgcn_s_getreg((3 << 11) | 20) & 0xFu; }
#define XB_SPIN(cond, bar) do { unsigned _sp = 0; while (cond) { __builtin_amdgcn_s_sleep(1); \
    if ((++_sp & 255u) == 0u) { if (xb_ld(&(bar)[XB_TMO])) break; if (_sp > XB_SPIN_CAP) { atomicAdd(&(bar)[XB_TMO], 1u); break; } } } } while (0)
struct XcdBarrier { unsigned* bar; unsigned x; volatile LAS unsigned* st; };
__device__ __forceinline__ XcdBarrier xcd_barrier_post(unsigned* bar, volatile LAS unsigned* st) {
    XcdBarrier b; b.bar = bar; b.x = xb_xcc_id(); b.st = st;
    if (threadIdx.x == 0) (void)xb_add(&bar[XB_XCNT(b.x)], 1u);
    return b;
}
__device__ __forceinline__ void xcd_barrier_complete(unsigned* bar, unsigned x, unsigned& nloc, unsigned& nx) {
    const unsigned G = gridDim.x * gridDim.y * gridDim.z;
    unsigned sum, cnt, mine, sp = 0u;
    for (;;) {
        sum = 0u; cnt = 0u; mine = 0u;
#pragma unroll
        for (unsigned j = 0; j < 16; ++j) { const unsigned c = xb_ld(&bar[XB_XCNT(j)]); sum += c; cnt += (c > 0u) ? 1u : 0u; mine = (j == x) ? c : mine; }
        if (sum == G) break;
        __builtin_amdgcn_s_sleep(1);
        if ((++sp & 255u) == 0u) { if (xb_ld(&bar[XB_TMO])) break; if (sp > XB_SPIN_CAP) { atomicAdd(&bar[XB_TMO], 1u); break; } }
    }
    nloc = mine > 0u ? mine : 1u; nx = cnt > 0u ? cnt : 1u;
}
__device__ __forceinline__ void xcd_barrier(const XcdBarrier& b, const int tid) {
    asm volatile("s_waitcnt vmcnt(0)" ::: "memory");
    __syncthreads();
    if (tid == 0) {
        unsigned* bar = b.bar;
        __builtin_amdgcn_s_waitcnt(0);
        unsigned nloc = b.st[0], nx = b.st[1];
        if (nloc == 0u) { xcd_barrier_complete(bar, b.x, nloc, nx); b.st[0] = nloc; b.st[1] = nx; }
        const unsigned old = xb_add(&bar[XB_XSUB(b.x)], 1u);
        const unsigned gen = old / nloc;
        if (old + 1u == (gen + 1u) * nloc) {
            __builtin_amdgcn_fence(__ATOMIC_RELEASE, "agent");
            asm volatile("s_waitcnt vmcnt(0)" ::: "memory");
            const unsigned og = xb_add(&bar[XB_TOP], 1u);
            const unsigned tg = og / nx;
            if (og + 1u == (tg + 1u) * nx) xb_add(&bar[XB_TOPGEN], 1u);
            else XB_SPIN(xb_ld(&bar[XB_TOPGEN]) == tg, bar);
            __builtin_amdgcn_fence(__ATOMIC_ACQUIRE, "agent");
            xb_add(&bar[XB_XGEN(b.x)], 1u);
            asm volatile("s_waitcnt vmcnt(0)" ::: "memory");
        } else {
            XB_SPIN(xb_ld(&bar[XB_XGEN(b.x)]) == gen, bar);
            __builtin_amdgcn_fence(__ATOMIC_ACQUIRE, "agent");
            asm volatile("s_waitcnt vmcnt(0)" ::: "memory");
        }
    }
    __syncthreads();
}

__device__ __forceinline__ void transpose_item(const float* W, int K, int N, bf16* WT, int ldt, int koff, int mode, LAS float* scr, int item, int lane) {
    const int nblk = N / 32, kb = item / nblk, nb = item % nblk, k0 = 64 * kb, n0 = 32 * nb;
#pragma unroll 8
    for (int i = 0; i < 32; ++i) { const int kk = 2 * i + (lane >> 5); scr[kk * 33 + (lane & 31)] = ((const GAS float*)W)[(size_t)(k0 + kk) * N + n0 + (lane & 31)]; }
    LDS_WAIT(); asm volatile("" ::: "memory");
    int drow0 = n0; float sc = 1.f;
    if (mode == 1) { const int half = n0 / DFF, ch = n0 - half * DFF; drow0 = 256 * (ch >> 7) + 128 * half + (ch & 127); }
    if (mode == 2 && n0 >= 1024 && n0 < 2048) sc = 0.0625f;
    const int c = lane & 7;
#pragma unroll
    for (int j = 0; j < 4; ++j) { const int n = (lane >> 3) + 8 * j; const LAS float* s = scr + (8 * c) * 33 + n;
        u32x4 o; o.x = pk2(s[0 * 33] * sc, s[1 * 33] * sc); o.y = pk2(s[2 * 33] * sc, s[3 * 33] * sc); o.z = pk2(s[4 * 33] * sc, s[5 * 33] * sc); o.w = pk2(s[6 * 33] * sc, s[7 * 33] * sc);
        *(GAS u32x4*)(WT + (size_t)(drow0 + n) * ldt + koff + k0 + 8 * c) = o; }
    LDS_WAIT(); asm volatile("" ::: "memory");
}

__device__ __forceinline__ void ada_unit(const float* c, const float* ada_w, float* modp, LAS unsigned char* lds, int au, int tid, int wave, int lane) {
    const int cg = au % 72, kh = au / 72;
    LAS float* scs = (LAS float*)lds;
    LAS float* red = (LAS float*)(lds + 32768);
    for (int idx = tid; idx < 512 * 16; idx += NTHREADS) { const int kk = idx >> 4, b = idx & 15; scs[idx] = siluf_(((const GAS float*)c)[b * D + kh * 512 + kk]); }
    __syncthreads();
    f32x2 acc[16];
#pragma unroll
    for (int b = 0; b < 16; ++b) acc[b] = (f32x2){0.f, 0.f};
    const float* wp = ada_w + (size_t)(kh * 512 + wave * 64) * INW + cg * 128 + 2 * lane;
#pragma unroll 1
    for (int k8 = 0; k8 < 64; k8 += 8) {
        f32x2 w[8];
#pragma unroll
        for (int i = 0; i < 8; ++i) w[i] = *(const GAS f32x2*)(wp + (size_t)(k8 + i) * INW);
#pragma unroll
        for (int i = 0; i < 8; ++i) { const LAS f32x4* sp = (const LAS f32x4*)(scs + (wave * 64 + k8 + i) * 16);
#pragma unroll
            for (int q = 0; q < 4; ++q) { const f32x4 s = sp[q];
                acc[4 * q + 0] += w[i] * s[0]; acc[4 * q + 1] += w[i] * s[1]; acc[4 * q + 2] += w[i] * s[2]; acc[4 * q + 3] += w[i] * s[3]; } }
    }
#pragma unroll
    for (int b = 0; b < 16; ++b) *(LAS f32x2*)(red + (wave * 16 + b) * 128 + 2 * lane) = acc[b];
    __syncthreads();
    for (int o = tid; o < 16 * 128; o += NTHREADS) { float s = 0.f;
#pragma unroll
        for (int w = 0; w < 8; ++w) s += red[w * 2048 + o];
        const int b = o >> 7, col = o & 127; ((GAS float*)modp)[(size_t)kh * (16 * INW) + b * INW + cg * 128 + col] = s; }
    __syncthreads();
}

__device__ __forceinline__ void rope_entry(float* cosT, float* sinT, int idx) {
    const int pos = idx >> 7, i = idx & 127;
    double inv = 1.0, rr = 0.9305720409296989; int e = i;
#pragma unroll
    for (int s = 0; s < 7; ++s) { if (e & 1) inv *= rr; rr *= rr; e >>= 1; }
    const float ang = (float)pos * (float)inv;
    const double a = (double)ang, kq = __builtin_rint(a * 0.6366197723675814), r = __builtin_fma(-kq, 1.5707963267948966, a) - kq * 6.123233995736766e-17, r2 = r * r;
    double sp = -7.647163731819816e-13; sp = sp * r2 + 1.605904383682161e-10; sp = sp * r2 - 2.505210838544172e-08; sp = sp * r2 + 2.755731922398589e-06; sp = sp * r2 - 1.984126984126984e-04; sp = sp * r2 + 8.333333333333333e-03; sp = sp * r2 - 1.666666666666667e-01;
    const double sr = r + r * r2 * sp;
    double cp = 4.779477332387385e-14; cp = cp * r2 - 1.147074559772972e-11; cp = cp * r2 + 2.087675698786810e-09; cp = cp * r2 - 2.755731922398589e-07; cp = cp * r2 + 2.480158730158730e-05; cp = cp * r2 - 1.388888888888889e-03; cp = cp * r2 + 4.166666666666666e-02; cp = cp * r2 - 0.5;
    const double cr = 1.0 + r2 * cp;
    const int qd = ((int)kq) & 3;
    const double sv = (qd == 0) ? sr : (qd == 1) ? cr : (qd == 2) ? -sr : -cr;
    const double cv = (qd == 0) ? cr : (qd == 1) ? -sr : (qd == 2) ? -cr : sr;
    ((GAS float*)cosT)[idx] = (float)cv; ((GAS float*)sinT)[idx] = (float)sv;
}

__device__ __forceinline__ void wc_unit(const float* lin, const float* pscale, const float* wp, float* wcf, int wu, int lane) {
    const int gc0 = (wu >> 1) * 4, n = (wu & 1) * 512 + 8 * lane, g = gc0 >> 8;
    f32x4 acc[4][2];
#pragma unroll
    for (int r = 0; r < 4; ++r) { acc[r][0] = (f32x4){0.f, 0.f, 0.f, 0.f}; acc[r][1] = (f32x4){0.f, 0.f, 0.f, 0.f}; }
#pragma unroll 4
    for (int d = 0; d < 256; ++d) {
        const float* wrow = wp + (size_t)(256 * g + d) * D + n; const f32x4 w0 = *(const GAS f32x4*)wrow, w1 = *(const GAS f32x4*)(wrow + 4);
        const float ps = ((const GAS float*)pscale)[256 * g + d];
#pragma unroll
        for (int r = 0; r < 4; ++r) { const float a = ((const GAS float*)lin)[(size_t)(gc0 + r) * 256 + d] * ps; acc[r][0] += w0 * a; acc[r][1] += w1 * a; }
    }
#pragma unroll
    for (int r = 0; r < 4; ++r) { float* o = wcf + (size_t)(gc0 + r) * D + n; *(GAS f32x4*)o = acc[r][0]; *(GAS f32x4*)(o + 4) = acc[r][1]; }
}

__device__ __forceinline__ void norm_rows(const float* x, const float* nw, const float* modf, const float* modp, const float* ada_b, int shoff, bf16* h, int gw, int NGW, int lane) {
    for (int rb = gw; rb < M / 16; rb += NGW) {
        const int row0 = rb * 16, b = row0 >> 11;
        f32x4 A[4], Bc[4];
#pragma unroll
        for (int j = 0; j < 4; ++j) { const int col = 4 * lane + 256 * j; f32x4 sh, sc;
            if (modp) { const float* p0 = modp + (size_t)b * INW + shoff + col; const float* p1 = p0 + 16 * INW;
                sh = *(const GAS f32x4*)p0 + *(const GAS f32x4*)p1 + *(const GAS f32x4*)(ada_b + shoff + col);
                sc = *(const GAS f32x4*)(p0 + D) + *(const GAS f32x4*)(p1 + D) + *(const GAS f32x4*)(ada_b + shoff + D + col); }
            else { const float* p = modf + (size_t)b * INW + shoff + col; sh = *(const GAS f32x4*)p; sc = *(const GAS f32x4*)(p + D); }
            A[j] = *(const GAS f32x4*)(nw + col) * (sc + 1.0f); Bc[j] = sh; }
#pragma unroll 2
        for (int r = 0; r < 16; ++r) {
            const GAS f32x4* xr = (const GAS f32x4*)(x + (size_t)(row0 + r) * D) + lane;
            f32x4 v[4]; float s = 0.f;
#pragma unroll
            for (int j = 0; j < 4; ++j) { v[j] = xr[64 * j]; s += (v[j].x * v[j].x + v[j].y * v[j].y) + (v[j].z * v[j].z + v[j].w * v[j].w); }
            const float rstd = 1.0f / sqrtf(wave_sum(s, lane) * (1.f / D) + EPS);
            GAS u32x2* o8 = (GAS u32x2*)(h + (size_t)(row0 + r) * D) + lane;
#pragma unroll
            for (int j = 0; j < 4; ++j) { const f32x4 y = v[j] * rstd * A[j] + Bc[j]; u32x2 w; w.x = pk2(y.x, y.y); w.y = pk2(y.z, y.w); o8[64 * j] = w; }
        }
    }
}
__device__ __forceinline__ void final_norm_rows(float* xo, const float* nw, int gw, int NGW, int lane) {
    f32x4 A[4];
#pragma unroll
    for (int j = 0; j < 4; ++j) A[j] = *(const GAS f32x4*)(nw + 4 * lane + 256 * j);
    for (int row = gw; row < M; row += NGW) {
        GAS f32x4* xr = (GAS f32x4*)(xo + (size_t)row * D) + lane;
        f32x4 v[4]; float s = 0.f;
#pragma unroll
        for (int j = 0; j < 4; ++j) { v[j] = xr[64 * j]; s += (v[j].x * v[j].x + v[j].y * v[j].y) + (v[j].z * v[j].z + v[j].w * v[j].w); }
        const float rstd = 1.0f / sqrtf(wave_sum(s, lane) * (1.f / D) + EPS);
#pragma unroll
        for (int j = 0; j < 4; ++j) xr[64 * j] = v[j] * rstd * A[j];
    }
}

namespace ret {
constexpr int KS_STR = 544, VS_STR = 160, ST_STR = 544;
constexpr int KS_OFF = 0, VS_OFF = 128 * KS_STR, ST_OFF = VS_OFF + 128 * VS_STR, END_OFF = ST_OFF + 64 * ST_STR;
static_assert(END_OFF <= 131072, "retention LDS map");
__device__ __forceinline__ s16x4 trd(LAS unsigned char* p) { return __builtin_bit_cast(s16x4, __builtin_amdgcn_ds_read_tr16_b64_v4i16((LAS s16x4*)p)); }
__device__ __forceinline__ bf16x8 cat(s16x4 a, s16x4 b) { return (bf16x8){a[0], a[1], a[2], a[3], b[0], b[1], b[2], b[3]}; }
#define MFMA16(a, b, c) __builtin_amdgcn_mfma_f32_16x16x32_bf16((a), (b), (c), 0, 0, 0)

__device__ __forceinline__ void unit(bf16* P  , f32x2* stats, int uidx, LAS unsigned char* lds, int tid, int wave, int lane) {
    const int es = uidx & 7, bh = uidx >> 3, h = bh & 3, bl = bh >> 2;
    const int r16 = lane & 15, qq = lane >> 4, rho = (lane >> 2) & 3, p4 = lane & 3;
    const int it = (wave < 4) ? wave : 11 - wave;
    const float lg2 = __builtin_amdgcn_logf(1.0f - __builtin_amdgcn_exp2f(-5.0f - (float)h));
    bf16* rowp = P + (size_t)(bl * SEQ) * INW;
    const int qcol = h * 256, kcol = 1024 + h * 256, vcol = 2048 + h * 512 + es * 64;
    for (int i = tid; i < 64 * ST_STR / 16; i += NTHREADS) *(LAS u32x4*)(lds + ST_OFF + i * 16) = (u32x4){0u, 0u, 0u, 0u};
    f32x4 accS[2][4];
#pragma unroll
    for (int a = 0; a < 2; ++a)
#pragma unroll
        for (int e = 0; e < 4; ++e) accS[a][e] = (f32x4){0.f, 0.f, 0.f, 0.f};
    const float g128 = __builtin_amdgcn_exp2f(lg2 * 128.f), gm32 = __builtin_amdgcn_exp2f(lg2 * -32.f), gm128 = __builtin_amdgcn_exp2f(lg2 * -128.f);
    float kdl[8];
#pragma unroll
    for (int jj = 0; jj < 8; ++jj) { const int jl = (jj < 4) ? (4 * qq + jj) : (16 + 4 * qq + jj - 4); kdl[jj] = __builtin_amdgcn_exp2f(lg2 * (float)(127 - jl)); }
    const float gq = __builtin_amdgcn_exp2f(lg2 * (float)(16 * it + r16 + 1));
    u32x4 kst[8], vst[2];
    const bf16* const kbase0 = rowp + (size_t)(tid >> 5) * INW + kcol + 8 * (tid & 31);
    const bf16* const vbase0 = rowp + (size_t)(tid >> 3) * INW + vcol + 8 * (tid & 7);
    const bf16* const qbase0 = rowp + (size_t)(16 * it + r16) * INW + qcol + 8 * qq;
    const int kw_off = KS_OFF + (tid >> 5) * KS_STR + (tid & 31) * 16, vw_off = VS_OFF + (tid >> 3) * VS_STR + (tid & 7) * 16;
    auto stage_load = [&](int t0) {
        const bf16* kb = kbase0 + (size_t)t0 * INW; const bf16* vb = vbase0 + (size_t)t0 * INW;
        asm volatile("" : "+v"(kb), "+v"(vb));
#pragma unroll
        for (int i = 0; i < 8; ++i) kst[i] = *(const GAS u32x4*)(kb + (size_t)(16 * i) * INW);
#pragma unroll
        for (int i = 0; i < 2; ++i) vst[i] = *(const GAS u32x4*)(vb + (size_t)(64 * i) * INW);
    };
    auto stage_write = [&]() {
#pragma unroll
        for (int i = 0; i < 8; ++i) *(LAS u32x4*)(lds + kw_off + i * 16 * KS_STR) = kst[i];
#pragma unroll
        for (int i = 0; i < 2; ++i) *(LAS u32x4*)(lds + vw_off + i * 64 * VS_STR) = vst[i];
    };
    bf16x8 qf[8];
    auto q_load = [&](int t0) {
        const bf16* qb = qbase0 + (size_t)t0 * INW; asm volatile("" : "+v"(qb));
#pragma unroll
        for (int ks = 0; ks < 8; ++ks) qf[ks] = *(const GAS bf16x8*)(qb + 32 * ks);
    };
    stage_load(0); q_load(0);
    stage_write();
    __syncthreads();
    LAS unsigned char* const ks_row = lds + KS_OFF + r16 * KS_STR + qq * 16;
    LAS unsigned char* const st_row = lds + ST_OFF + r16 * ST_STR + qq * 16;
    LAS unsigned char* const v_tr = lds + VS_OFF + (4 * qq + rho) * VS_STR + p4 * 8;
    LAS unsigned char* const k_tr = lds + KS_OFF + (4 * qq + rho) * KS_STR + (32 * wave) * 2 + p4 * 8;
#pragma unroll 1
    for (int c = 0; c < 16; ++c) {
        const int t0 = c * 128;
        if (c + 1 < 16) stage_load(t0 + 128);
        f32x4 ax[4];
#pragma unroll
        for (int et = 0; et < 4; ++et) { ax[et] = (f32x4){0.f, 0.f, 0.f, 0.f};
#pragma unroll
            for (int ks = 0; ks < 8; ++ks) { const bf16x8 a = *(const LAS bf16x8*)(st_row + et * 16 * ST_STR + ks * 64); ax[et] = MFMA16(a, qf[ks], ax[et]); }
            asm volatile("" ::: "memory"); }
        {
            float gsp = gm128;
#pragma unroll 1
            for (int s = 0; s < 4; ++s) {
                if (2 * s <= it) {
                    f32x4 s0 = (f32x4){0.f, 0.f, 0.f, 0.f}, s1 = (f32x4){0.f, 0.f, 0.f, 0.f};
#pragma unroll
                    for (int ks = 0; ks < 8; ++ks) { const bf16x8 a = *(const LAS bf16x8*)(ks_row + (2 * s) * 16 * KS_STR + ks * 64); s0 = MFMA16(a, qf[ks], s0); }
                    asm volatile("" ::: "memory");
                    if (2 * s + 1 <= it) {
#pragma unroll
                        for (int ks = 0; ks < 8; ++ks) { const bf16x8 a = *(const LAS bf16x8*)(ks_row + (2 * s + 1) * 16 * KS_STR + ks * 64); s1 = MFMA16(a, qf[ks], s1); }
                    }
                    asm volatile("" ::: "memory");
#pragma unroll
                    for (int reg = 0; reg < 4; ++reg) { s0[reg] *= kdl[reg] * gsp; s1[reg] *= kdl[4 + reg] * gsp; }
                    if (2 * s == it) {
#pragma unroll
                        for (int reg = 0; reg < 4; ++reg) s0[reg] = (4 * qq + reg <= r16) ? s0[reg] : 0.f;
                    }
                    if (2 * s + 1 == it) {
#pragma unroll
                        for (int reg = 0; reg < 4; ++reg) s1[reg] = (4 * qq + reg <= r16) ? s1[reg] : 0.f;
                    }
                    u32x4 pw; pw.x = pk2(s0[0], s0[1]); pw.y = pk2(s0[2], s0[3]); pw.z = pk2(s1[0], s1[1]); pw.w = pk2(s1[2], s1[3]);
                    const bf16x8 pf = __builtin_bit_cast(bf16x8, pw);
#pragma unroll
                    for (int et = 0; et < 4; ++et) { const s16x4 lo = trd(v_tr + s * 32 * VS_STR + et * 32), hi = trd(v_tr + s * 32 * VS_STR + 16 * VS_STR + et * 32);
                        ax[et] = MFMA16(cat(lo, hi), pf, ax[et]); }
                    asm volatile("" ::: "memory");
                }
                gsp *= gm32;
            }
        }
        if (c + 1 < 16) q_load(t0 + 128);
        {
            float s1 = 0.f, s2 = 0.f; const size_t lrow = (size_t)(bl * SEQ + t0 + 16 * it + r16);
            bf16* op = P + lrow * INW + vcol + 4 * qq;
#pragma unroll
            for (int et = 0; et < 4; ++et) { const f32x4 o = ax[et] * gq;
                s1 += (o[0] + o[1]) + (o[2] + o[3]); s2 += (o[0] * o[0] + o[1] * o[1]) + (o[2] * o[2] + o[3] * o[3]);
                u32x2 w; w.x = pk2(o[0], o[1]); w.y = pk2(o[2], o[3]); *(GAS u32x2*)(op + 16 * et) = w; }
            s1 += shx(s1, 16, lane); s1 += shx(s1, 32, lane); s2 += shx(s2, 16, lane); s2 += shx(s2, 32, lane);
            if (qq == 0) ((GAS f32x2*)stats)[(lrow * 4 + h) * 8 + es] = (f32x2){s1, s2};
        }
        asm volatile("" ::: "memory");
#pragma unroll
        for (int a = 0; a < 2; ++a)
#pragma unroll
            for (int e = 0; e < 4; ++e) accS[a][e] *= g128;
        float gs = 1.0f;
#pragma unroll
        for (int s = 0; s < 4; ++s) {
            bf16x8 kf[2];
#pragma unroll
            for (int dkt = 0; dkt < 2; ++dkt) { const s16x4 lo = trd(k_tr + s * 32 * KS_STR + dkt * 32), hi = trd(k_tr + s * 32 * KS_STR + 16 * KS_STR + dkt * 32);
                const u32x4 raw = __builtin_bit_cast(u32x4, cat(lo, hi)); u32x4 sc;
#pragma unroll
                for (int j = 0; j < 4; ++j) sc[j] = pk2(bf_lo(raw[j]) * (kdl[2 * j] * gs), bf_hi(raw[j]) * (kdl[2 * j + 1] * gs));
                kf[dkt] = __builtin_bit_cast(bf16x8, sc); }
#pragma unroll
            for (int et = 0; et < 4; ++et) { const s16x4 lo = trd(v_tr + s * 32 * VS_STR + et * 32), hi = trd(v_tr + s * 32 * VS_STR + 16 * VS_STR + et * 32);
                const bf16x8 vf = cat(lo, hi);
                accS[0][et] = MFMA16(kf[0], vf, accS[0][et]); accS[1][et] = MFMA16(kf[1], vf, accS[1][et]); }
            asm volatile("" ::: "memory");
            gs *= gm32;
        }
        __syncthreads();
#pragma unroll
        for (int dkt = 0; dkt < 2; ++dkt)
#pragma unroll
            for (int et = 0; et < 4; ++et) { const f32x4 v = accS[dkt][et]; u32x2 w; w.x = pk2(v[0], v[1]); w.y = pk2(v[2], v[3]);
                *(LAS u32x2*)(lds + ST_OFF + (16 * et + r16) * ST_STR + (32 * wave + 16 * dkt + 4 * qq) * 2) = w; }
        if (c + 1 < 16) stage_write();
        __syncthreads();
    }
}
}

constexpr int SHL_STR = 1032;
__device__ __forceinline__ void cbias_tiles(const bf16* WT, int N, float* cb, const LAS bf16* sh_hi, const LAS bf16* sh_lo, int gw, int NGW, int lane) {
    const int r16 = lane & 15, qq = lane >> 4;
    for (int tile = gw; tile < N / 16; tile += NGW) {
        const bf16* wp = WT + (size_t)(tile * 16 + r16) * D + 8 * qq;
        f32x4 acc = (f32x4){0.f, 0.f, 0.f, 0.f};
#pragma unroll 8
        for (int ks = 0; ks < 32; ++ks) {
            const bf16x8 bfrag = *(const GAS bf16x8*)(wp + 32 * ks);
            const bf16x8 ah = *(const LAS bf16x8*)(sh_hi + r16 * SHL_STR + 32 * ks + 8 * qq), al = *(const LAS bf16x8*)(sh_lo + r16 * SHL_STR + 32 * ks + 8 * qq);
            acc = __builtin_amdgcn_mfma_f32_16x16x32_bf16(ah, bfrag, acc, 0, 0, 0); acc = __builtin_amdgcn_mfma_f32_16x16x32_bf16(al, bfrag, acc, 0, 0, 0);
        }
#pragma unroll
        for (int reg = 0; reg < 4; ++reg) ((GAS float*)cb)[(size_t)(4 * qq + reg) * N + tile * 16 + r16] = acc[reg];
    }
}
__device__ __forceinline__ void gn_rows(bf16* P, const f32x2* stats, const float* gnw, int gw, int NGW, int lane) {
    const int hh = lane >> 4;
    f32x4 wv[8];
#pragma unroll
    for (int j = 0; j < 8; ++j) wv[j] = *(const GAS f32x4*)(gnw + 32 * lane + 4 * j);
    for (int row = gw; row < MH; row += 2 * NGW) {
        const int rowB = (row + NGW < MH) ? row + NGW : row;
        u32x4 raw[2][4], gg[2][4]; f32x4 st[2][4];
#pragma unroll
        for (int t = 0; t < 2; ++t) { const int r = t ? rowB : row; const bf16* rp = P + (size_t)r * INW + 32 * lane;
            const GAS f32x4* sp = (const GAS f32x4*)(stats + ((size_t)r * 4 + hh) * 8);
#pragma unroll
            for (int j = 0; j < 4; ++j) { raw[t][j] = *(const GAS u32x4*)(rp + 2048 + 8 * j); gg[t][j] = *(const GAS u32x4*)(rp + 4096 + 8 * j); st[t][j] = sp[j]; } }
#pragma unroll
        for (int t = 0; t < 2; ++t) { const int r = t ? rowB : row; bf16* rp = P + (size_t)r * INW + 32 * lane;
            float s1 = 0.f, s2 = 0.f;
#pragma unroll
            for (int j = 0; j < 4; ++j) { s1 += st[t][j].x + st[t][j].z; s2 += st[t][j].y + st[t][j].w; }
            const float mu = s1 * (1.f / 512.f), var = fmaxf(s2 * (1.f / 512.f) - mu * mu, 0.f), rstd = 1.0f / sqrtf(var + EPS);
            if (t == 0 || rowB != row) {
#pragma unroll
                for (int j = 0; j < 4; ++j) { u32x4 o;
#pragma unroll
                    for (int k = 0; k < 4; ++k) { const f32x4 w4 = wv[2 * j + (k >> 1)];
                        const float y0 = bf_lo(gg[t][j][k]) * (bf_lo(raw[t][j][k]) - mu) * rstd * w4[(k & 1) * 2], y1 = bf_hi(gg[t][j][k]) * (bf_hi(raw[t][j][k]) - mu) * rstd * w4[(k & 1) * 2 + 1];
                        o[k] = pk2(y0, y1); }
                    *(GAS u32x4*)(rp + 4096 + 8 * j) = o; } }
        }
    }
}
template <int W>
__device__ __forceinline__ void pool_block(bf16* P, int row0, int col) {
    const int pos0 = row0 & (SEQ - 1);
    const bf16* up = P + (size_t)row0 * INW + 6144 + col;
    u32x2 v[16 + W - 1];
#pragma unroll
    for (int i = 0; i < 16 + W - 1; ++i) { const int dr = i - (W - 1); v[i] = (u32x2){0u, 0u}; if (dr >= 0 || pos0 > 0) v[i] = *(const GAS u32x2*)(up + (ptrdiff_t)dr * INW); }
    float s0 = 0.f, s1 = 0.f, s2 = 0.f, s3 = 0.f;
#pragma unroll
    for (int i = 0; i < W - 1; ++i) { s0 += bf_lo(v[i].x); s1 += bf_hi(v[i].x); s2 += bf_lo(v[i].y); s3 += bf_hi(v[i].y); }
#pragma unroll
    for (int r = 0; r < 16; ++r) {
        const u32x2 c = v[r + W - 1];
        s0 += bf_lo(c.x); s1 += bf_hi(c.x); s2 += bf_lo(c.y); s3 += bf_hi(c.y);
        const int pos = pos0 + r; const float inv = 1.0f / (float)(pos + 1 < W ? pos + 1 : W);
        u32x2 o; o.x = pk2(s0 * inv - bf_lo(c.x), s1 * inv - bf_hi(c.x)); o.y = pk2(s2 * inv - bf_lo(c.y), s3 * inv - bf_hi(c.y));
        *(GAS u32x2*)(P + (size_t)(row0 + r) * INW + col) = o;
        const u32x2 t = v[r]; s0 -= bf_lo(t.x); s1 -= bf_hi(t.x); s2 -= bf_lo(t.y); s3 -= bf_hi(t.y);
    }
}
__device__ __forceinline__ void pool_units(bf16* P, int gw, int NGW, int lane) {
    for (int wu = gw; wu < (MH / 16) * 4; wu += NGW) {
        const int rb = wu >> 2, g = wu & 3, col = g * 256 + 4 * lane, row0 = rb * 16;
        if (g == 0) pool_block<2>(P, row0, col); else if (g == 1) pool_block<4>(P, row0, col); else if (g == 2) pool_block<8>(P, row0, col); else pool_block<16>(P, row0, col);
    }
}

struct Args { const float* in[19]; float* out; unsigned char* ws; int ph_lo, ph_hi; };
__device__ __forceinline__ const float* in_ptr(const Args& a, int i) { asm volatile("" : "+s"(i)); return a.in[i]; }

__global__ void __launch_bounds__(NTHREADS, 2) mk_fwd(Args args) {
    extern __shared__ __attribute__((aligned(16))) unsigned char lds_raw[];
    LAS unsigned char* lds = (LAS unsigned char*)lds_raw;
    volatile LAS unsigned* MISC = (volatile LAS unsigned*)(lds + MISC_OFF);
    const int G = gridDim.x; const int bx = blockIdx.x;
    const int wave0 = __builtin_amdgcn_readfirstlane(threadIdx.x >> 6);
    {
        unsigned* ctl0 = (unsigned*)(args.ws + WS_CTL);
        for (int u = threadIdx.x; u < (LDS_BYTES - 131072) / 4; u += NTHREADS) ((LAS unsigned*)(lds + 131072))[u] = 0u;
        __syncthreads();
    }
    XcdBarrier bar = xcd_barrier_post((unsigned*)(args.ws + WS_CTL) + CW_BAR, MISC + 8);

#define PHASE_PREAMBLE() \
        int wave = wave0; asm volatile("" : "+s"(wave)); \
        int lane; asm volatile("v_mbcnt_lo_u32_b32 %0, -1, 0\n\tv_mbcnt_hi_u32_b32 %0, -1, %0" : "=v"(lane)); \
        const int tid = wave * 64 + lane; \
        unsigned char* ws = args.ws; asm volatile("" : "+s"(ws)); \
        const int vcu = (G % 8 == 0) ? (bx % 8) * (G / 8) + bx / 8 : bx; \
        const int gw = vcu * NWAVES + wave, NGW = G * NWAVES; \
        const float* x = in_ptr(args, 0); float* out = args.out; \
        float* modp = (float*)(ws + WS_MODP); float* modf = (float*)(ws + WS_MODF); \
        float* cosT = (float*)(ws + WS_COS); float* sinT = (float*)(ws + WS_SIN); \
        float* wcf = (float*)(ws + WS_WCF); f32x2* stats = (f32x2*)(ws + WS_STATS); \
        bf16* w13t1 = (bf16*)(ws + WS_W13T1); bf16* w13t2 = (bf16*)(ws + WS_W13T2); bf16* w2t1 = (bf16*)(ws + WS_W2T1); bf16* w2t2 = (bf16*)(ws + WS_W2T2); \
        bf16* wint = (bf16*)(ws + WS_WINT); bf16* bcat = (bf16*)(ws + WS_BCAT); bf16* woutt = (bf16*)(ws + WS_WOUT); \
        bf16* H = (bf16*)(ws + WS_H); bf16* BIG = (bf16*)(ws + WS_BIG); bf16* MERGED = (bf16*)(ws + WS_MERGED); \
        float* ssq = (float*)(ws + WS_SSQ); float* rstd = (float*)(ws + WS_RSTD); float* cbin = (float*)(ws + WS_CBIN); float* cbup = (float*)(ws + WS_CBUP);
    if (args.ph_lo == 0) {
        PHASE_PREAMBLE()
            if (vcu < 144) ada_unit(in_ptr(args, 1), in_ptr(args, 2), modp, lds, vcu, tid, wave, lane);
            for (int idx = gw * 64 + lane; idx < SEQ * 128; idx += NGW * 64) rope_entry(cosT, sinT, idx);
            for (int wu = gw; wu < 512; wu += NGW) wc_unit(in_ptr(args, 11), in_ptr(args, 12), in_ptr(args, 13), wcf, wu, lane);
            LAS float* scr = (LAS float*)(lds + wave * 16384);
            constexpr int I13 = (D / 64) * (2 * DFF / 32), I2 = (DFF / 64) * (D / 32), IIN = (D / 64) * (INW / 32), IR = (2048 / 64) * (D / 32), IO = (D / 64) * (D / 32);
            constexpr int NITEMS = 2 * I13 + 2 * I2 + IIN + IR + IO;
            for (int it = gw; it < NITEMS; it += NGW) {
                int r = it;
                if (r < I13) { transpose_item(in_ptr(args, 5), D, 2 * DFF, w13t1, D, 0, 1, scr, r, lane); continue; } r -= I13;
                if (r < I2) { transpose_item(in_ptr(args, 6), DFF, D, w2t1, DFF, 0, 0, scr, r, lane); continue; } r -= I2;
                if (r < IIN) { transpose_item(in_ptr(args, 8), D, INW, wint, D, 0, 2, scr, r, lane); continue; } r -= IIN;
                if (r < IR) { transpose_item(in_ptr(args, 10), 2048, D, bcat, 3072, 0, 0, scr, r, lane); continue; } r -= IR;
                if (r < IO) { transpose_item(in_ptr(args, 14), D, D, woutt, D, 0, 0, scr, r, lane); continue; } r -= IO;
                if (r < I13) { transpose_item(in_ptr(args, 16), D, 2 * DFF, w13t2, D, 0, 1, scr, r, lane); continue; } r -= I13;
                transpose_item(in_ptr(args, 17), DFF, D, w2t2, DFF, 0, 0, scr, r, lane);
            }
        if (args.ph_hi > 1) xcd_barrier(bar, tid);
    }
    constexpr int REP = REPEAT_PH, RLEN = REPEAT_LEN;
    const int i_hi = args.ph_hi + ((REP > 0 && args.ph_lo <= REP && REP < args.ph_hi) ? RLEN : 0);
    for (int i = (args.ph_lo > 1 ? args.ph_lo : 1); i < i_hi; ++i) {
        const int ph = (REP > 0 && i > REP + RLEN - 1) ? i - RLEN : i;
        PHASE_PREAMBLE()
        if (ph == 1) {
            for (int idx = (gw * 64 + lane) * 4; idx < 16 * INW; idx += NGW * 64 * 4)
                *(GAS f32x4*)(modf + idx) = *(const GAS f32x4*)(modp + idx) + *(const GAS f32x4*)(modp + 16 * INW + idx) + *(const GAS f32x4*)(in_ptr(args, 3) + (idx % INW));
            LAS float* scr = (LAS float*)(lds + wave * 16384);
            for (int it = gw; it < (D / 64) * (D / 32); it += NGW) transpose_item(wcf, D, D, bcat, 3072, 2048, 0, scr, it, lane);
            __syncthreads();
            { LAS bf16* shl = (LAS bf16*)lds; const float* ab = in_ptr(args, 3);
#pragma unroll 1
                for (int set = 0; set < 2; ++set) {
                    for (int idx = tid * 4; idx < 16 * D; idx += NTHREADS * 4) { const int bb = idx >> 10, k = idx & 1023; const size_t o = (size_t)bb * INW + (set ? 6 * D : 3 * D) + k;
                        const f32x4 v = *(const GAS f32x4*)(modp + o) + *(const GAS f32x4*)(modp + 16 * INW + o) + *(const GAS f32x4*)(ab + (set ? 6 * D : 3 * D) + k);
                        u32x2 hi; hi.x = pk2(v[0], v[1]); hi.y = pk2(v[2], v[3]);
                        u32x2 lo; lo.x = pk2(v[0] - bf_lo(hi.x), v[1] - bf_hi(hi.x)); lo.y = pk2(v[2] - bf_lo(hi.y), v[3] - bf_hi(hi.y));
                        *(LAS u32x2*)(shl + bb * SHL_STR + k) = hi; *(LAS u32x2*)(shl + 16 * SHL_STR + bb * SHL_STR + k) = lo; }
                    __syncthreads();
                    if (set == 0) cbias_tiles(wint, INW, cbin, shl, shl + 16 * SHL_STR, gw, NGW, lane);
                    else cbias_tiles(w13t2, 2 * DFF, cbup, shl, shl + 16 * SHL_STR, gw, NGW, lane);
                    __syncthreads();
                }
            }
            norm_rows(x, in_ptr(args, 4), modf, modp, in_ptr(args, 3), 0, H, gw, NGW, lane);
        } else if (ph == 2 || ph == 16) {
            pg8::Gemm g{H, ph == 2 ? w13t1 : w13t2, D, D, D, 1 << 30, 0};
#if defined(PROBE_NOEPI)
            if (REP > 0 && i == REP) { g.noepi = 1; g.K = PROBE_K; }
#endif
            pg8::StaticOrder S; S.init(M, 2 * DFF, G, bx);
            pg8::EpiSwiGLU E{BIG, ph == 2 ? nullptr : rstd, cbup};
            pg8::gemm_phase<pg8::EpiSwiGLU>(lds, g, S, E, tid);
        } else if (ph == 3 || ph == 17 || ph == 9 || ph == 14) {
            const bool dn = (ph == 3 || ph == 17); const int hb = (ph == 14) ? 1 : 0;
            const bf16* Ap = dn ? BIG : MERGED; const bf16* Bp = (ph == 3) ? w2t1 : (ph == 17) ? w2t2 : woutt; const int Kd = dn ? DFF : D;
            const float* basep = (ph == 3) ? x : out; const float* gatep = modf + ((ph == 3) ? 2 * D : (ph == 17) ? 8 * D : 5 * D);
            bf16* xsp = (ph == 17) ? nullptr : H; const float* nwp = in_ptr(args, (ph == 3) ? 7 : 15); const float* scp = modf + ((ph == 3) ? 4 * D : 7 * D);
            pg8::Gemm g{Ap, Bp, Kd, Kd, Kd, 1 << 30, 0};
            pg8::StaticOrder S; S.init(dn ? M : MH, D, G, bx);
            pg8::EpiResid E{basep, out, gatep, xsp, nwp, scp, ssq, dn ? 0.5f : 1.0f, hb * MH};
            pg8::gemm_phase<pg8::EpiResid>(lds, g, S, E, tid);
        } else if (ph == 4 || ph == 15) {
            for (int row = gw * 64 + lane; row < M; row += NGW * 64) { const GAS f32x4* p = (const GAS f32x4*)(ssq + (size_t)row * 16); const f32x4 a = p[0], b = p[1], c = p[2], d = p[3];
                const float s = ((a[0] + a[1]) + (a[2] + a[3])) + ((b[0] + b[1]) + (b[2] + b[3])) + ((c[0] + c[1]) + (c[2] + c[3])) + ((d[0] + d[1]) + (d[2] + d[3]));
                ((GAS float*)rstd)[row] = 1.0f / sqrtf(s * (1.f / D) + EPS); }
        } else if (ph == 5 || ph == 10) {
            const int hb = (ph == 10);
            pg8::Gemm g{H + (size_t)hb * MH * D, wint, D, D, D, 1 << 30, 0};
            pg8::StaticOrder S; S.init(MH, INW, G, bx);
            pg8::EpiProj E{BIG, cosT, sinT, hb * MH, rstd, cbin};
            pg8::gemm_phase<pg8::EpiProj>(lds, g, S, E, tid);
        } else if (ph == 6 || ph == 11) {
            for (int u = vcu; u < 256; u += G) ret::unit(BIG, stats, u, lds, tid, wave, lane);
        } else if (ph == 7 || ph == 12) {
            gn_rows(BIG, stats, in_ptr(args, 9), gw, NGW, lane);
            pool_units(BIG, gw, NGW, lane);
        } else if (ph == 8 || ph == 13) {
            pg8::Gemm g{BIG + 4096, bcat, INW, 3072, 3072, 32, -(long)(4096 * 2 + 32 * 128)};
            pg8::StaticOrder S; S.init(MH, D, G, bx);
            pg8::EpiMerged E{BIG, MERGED};
            pg8::gemm_phase<pg8::EpiMerged>(lds, g, S, E, tid);
        } else {
            final_norm_rows(out, in_ptr(args, 18), gw, NGW, lane);
        }
        if (i + 1 < i_hi) xcd_barrier(bar, tid);
        if (EXTRA_BARRIERS > 0 && i == 2) { for (int e = 0; e < EXTRA_BARRIERS; ++e) xcd_barrier(bar, tid); }
    }
}

extern "C" void kernel_launch(void* const* d_in, const int* in_sizes, int n_in, void* d_out, int out_size, void* d_ws, size_t ws_size, hipStream_t stream) {
    static int grid = 0;
    if (grid == 0) {
        if (n_in != 19 || in_sizes[0] != M * D || out_size != M * D || ws_size < WS_END) { fprintf(stderr, "kernel_launch: unexpected shapes (n_in %d, in0 %d, out %d, ws %zu)\n", n_in, n_in > 0 ? in_sizes[0] : -1, out_size, ws_size); grid = -1; return; }
        int dev = 0, cus = 0, per_cu = 0;
        if (hipGetDevice(&dev) != hipSuccess || hipDeviceGetAttribute(&cus, hipDeviceAttributeMultiprocessorCount, dev) != hipSuccess) { grid = -1; return; }
        if (hipFuncSetAttribute((const void*)mk_fwd, hipFuncAttributeMaxDynamicSharedMemorySize, LDS_BYTES) != hipSuccess) { fprintf(stderr, "kernel_launch: hipFuncSetAttribute failed\n"); grid = -1; return; }
        if (hipOccupancyMaxActiveBlocksPerMultiprocessor(&per_cu, (const void*)mk_fwd, NTHREADS, LDS_BYTES) != hipSuccess || per_cu < 1) { fprintf(stderr, "kernel_launch: occupancy query says %d blocks per CU\n", per_cu); (void)hipGetLastError(); grid = -1; return; }
        grid = cus;
    }
    if (grid < 0) return;
    (void)hipMemsetAsync((char*)d_ws + WS_CTL, 0, CTL_ZERO_BYTES, stream);
    Args a{};
    for (int i = 0; i < 19; ++i) a.in[i] = (const float*)d_in[i];
    a.out = (float*)d_out; a.ws = (unsigned char*)d_ws;
#if MK_ONE_LAUNCH
    a.ph_lo = 0; a.ph_hi = N_PHASES;
    hipLaunchKernelGGL(mk_fwd, dim3(grid), dim3(NTHREADS), LDS_BYTES, stream, a);
#else
    for (int ph = 0; ph < N_PHASES; ++ph) { a.ph_lo = ph; a.ph_hi = ph + 1; hipLaunchKernelGGL(mk_fwd, dim3(grid), dim3(NTHREADS), LDS_BYTES, stream, a); }
#endif
}
```

```cpp
#include <hip/hip_runtime.h>
#include <cstdio>
#include <cstdint>

#define LAS __attribute__((address_space(3)))
#define GAS __attribute__((address_space(1)))
typedef unsigned short bf16;
typedef short bf16x8 __attribute__((ext_vector_type(8)));
typedef short s16x4 __attribute__((ext_vector_type(4)));
typedef float f32x4 __attribute__((ext_vector_type(4)));
typedef float f32x2 __attribute__((ext_vector_type(2)));
typedef unsigned u32x4 __attribute__((ext_vector_type(4)));
typedef unsigned u32x2 __attribute__((ext_vector_type(2)));
typedef __bf16 bf16x2_t __attribute__((ext_vector_type(2)));

#ifndef MK_ONE_LAUNCH
#define MK_ONE_LAUNCH 1
#endif
#ifndef REPEAT_PH
#define REPEAT_PH -1
#endif
#ifndef REPEAT_LEN
#define REPEAT_LEN 1
#endif
#ifndef EXTRA_BARRIERS
#define EXTRA_BARRIERS 0
#endif

constexpr int D = 1024, NB = 16, SEQ = 2048, M = NB * SEQ, DFF = 2816, INW = 9216;
constexpr int MH = M / 2;
constexpr float EPS = 1e-6f;
constexpr int NWAVES = 8, NTHREADS = 512;
constexpr int N_PHASES = 19;

constexpr size_t MiB = 1u << 20;
constexpr size_t WS_CTL = 0, CTL_ZERO_BYTES = 64 * 1024;
constexpr size_t WS_MODP = 1 * MiB;
constexpr size_t WS_MODF = 3 * MiB;
constexpr size_t WS_COS = 4 * MiB, WS_SIN = 5 * MiB;
constexpr size_t WS_WCF = 6 * MiB;
constexpr size_t WS_STATS = 10 * MiB;
constexpr size_t WS_W13T1 = 14 * MiB, WS_W13T2 = 25 * MiB, WS_W2T1 = 36 * MiB, WS_W2T2 = 42 * MiB;
constexpr size_t WS_WINT = 48 * MiB, WS_BCAT = 66 * MiB, WS_WOUT = 72 * MiB;
constexpr size_t WS_H = 74 * MiB;
constexpr size_t WS_BIG = 138 * MiB;
constexpr size_t WS_MERGED = 426 * MiB;
constexpr size_t WS_SSQ = 458 * MiB;
constexpr size_t WS_CBIN = 460 * MiB;
constexpr size_t WS_CBUP = 461 * MiB;
constexpr size_t WS_RSTD = 462 * MiB;
constexpr size_t WS_END = 463 * MiB;
constexpr int CW_BAR = 1024;

constexpr int LDS_BYTES = 147456;
constexpr int MISC_OFF = 131072 + 320;

__device__ __forceinline__ unsigned pk2(float lo, float hi) { f32x2 v = {lo, hi}; bf16x2_t b = __builtin_convertvector(v, bf16x2_t); return __builtin_bit_cast(unsigned, b); }
__device__ __forceinline__ float bf_lo(unsigned u) { return __uint_as_float(u << 16); }
__device__ __forceinline__ float bf_hi(unsigned u) { return __uint_as_float(u & 0xffff0000u); }
__device__ __forceinline__ float sigmoidf_(float x) { return __builtin_amdgcn_rcpf(1.f + __builtin_amdgcn_exp2f(-1.4426950408889634f * x)); }
__device__ __forceinline__ float siluf_(float x) { return x * sigmoidf_(x); }
__device__ __forceinline__ float shx(float v, int mask, int lane) { return __int_as_float(__builtin_amdgcn_ds_bpermute((lane ^ mask) << 2, __float_as_int(v))); }
__device__ __forceinline__ float wave_sum(float v, int lane) {
#pragma unroll
    for (int o = 1; o < 64; o <<= 1) v += shx(v, o, lane);
    return v;
}
#define LDS_WAIT() asm volatile("s_waitcnt lgkmcnt(0)" ::: "memory")
#define VM_WAIT() asm volatile("s_waitcnt vmcnt(0)" ::: "memory")

namespace pg8 {
#define PG8_LAS __attribute__((address_space(3)))
typedef unsigned short bf16_t;
constexpr int BM = 256, BK = 64, HALF = 128, HTB = HALF * BK * 2, STAGE_BYTES = 8 * HTB, NXCD = 8, WGM = 4;

__host__ __device__ __forceinline__ int lds_byte(int r, int c) { const int st = (r >> 4) * 2 + (c >> 5), rr = r & 15, cc = c & 31, ob = rr * 64 + cc * 2; return st * 1024 + (ob ^ (((ob >> 9) & 1) << 5)); }
__host__ __device__ __forceinline__ void stage_rc(int b, int& R, int& C) { const int st = b / 1024, sb = b % 1024, swz = sb ^ (((sb >> 9) & 1) << 5); R = (st >> 1) * 16 + swz / 64; C = (st & 1) * 32 + (swz % 64) / 2; }
__host__ __device__ __forceinline__ int perm32(int rho) { const int n = rho >> 4, i = rho & 15; return 8 * (i >> 2) + 4 * n + (i & 3); }

struct Unit { int pm, pn; };
struct Gemm { const bf16_t* A; const bf16_t* Bt; int lda, ldb, K, tsplit; long adelta; int noepi = 0; };

struct StaticOrder {
    int nM, nN, nwg, G, c;
    __host__ __device__ void init(int M_, int N_, int G_, int c_) { nM = M_ / BM; nN = N_ / BM; nwg = nM * nN; G = G_; c = c_; }
    __host__ __device__ bool next(int i, Unit& u) const {
        const long L = (long)i * G + c; if (L >= nwg) return false;
        int wgid = (int)L; { const int q = nwg / NXCD, r = nwg % NXCD, xcd = wgid % NXCD, off = wgid / NXCD; wgid = (xcd < r ? xcd * (q + 1) : r * (q + 1) + (xcd - r) * q) + off; }
        const int nig = WGM * nN, gid = wgid / nig, fm = gid * WGM, gsz = (nM - fm) < WGM ? (nM - fm) : WGM;
        u.pm = fm + ((wgid % nig) % gsz); u.pn = (wgid % nig) / gsz; return true;
    }
};

template <class Epi, bool ALIGN_EPI = true>
__device__ __forceinline__ void gemm_phase(PG8_LAS unsigned char* lds, const Gemm g, const StaticOrder S, const Epi E, const int tid) {
    const int wid = __builtin_amdgcn_readfirstlane(tid >> 6), lane = tid & 63, wr = wid >> 2, wc = wid & 3, fr = lane & 15, fq = lane >> 4;
    const int K = g.K, nt = K / BK, tsplit = g.tsplit; const long adelta = g.adelta;
    unsigned voffA[2], voffB[2];
#pragma unroll
    for (int i = 0; i < 2; ++i) { int R, C; stage_rc(tid * 16 + i * 8192, R, C); const int Rb = Epi::PERM ? ((R & ~31) + perm32(R & 31)) : R;
        voffA[i] = (unsigned)(R * g.lda + C) * 2u; voffB[i] = (unsigned)(Rb * g.ldb + C) * 2u; }
    const size_t kstep = (size_t)(BK * 2);
    const size_t hstepA = (size_t)HALF * g.lda * 2, hstepB = (size_t)HALF * g.ldb * 2;
    const size_t tstepA = 2 * hstepA, tstepB = 2 * hstepB;
    const unsigned ldsw = (unsigned)wid * 1024u;
    const int aoff = lds_byte(wr * 64 + fr, fq * 8), boff = lds_byte(wc * 32 + fr, fq * 8);
#define PG8_SA(b, h) (((b) * 2 + (h)) * HTB)
#define PG8_SB(b, h) ((4 + (b) * 2 + (h)) * HTB)
#define PG8_STAGE(bufoff, gbase, voff) do { _Pragma("unroll") for (int _i = 0; _i < 2; ++_i) \
        __builtin_amdgcn_global_load_lds((const unsigned*)((const char*)(gbase) + (voff)[_i]), (PG8_LAS unsigned*)(lds + (bufoff) + ldsw + _i * 8192), 16, 0, 0); } while (0)
#define PG8_LDA(dst, b, h) do { _Pragma("unroll") for (int m = 0; m < 4; ++m) _Pragma("unroll") for (int k = 0; k < 2; ++k) dst[m][k] = *(const PG8_LAS bf16x8*)(lds + PG8_SA(b, h) + aoff + m * 2048 + k * 1024); } while (0)
#define PG8_LDB(dst, b, h) do { _Pragma("unroll") for (int n = 0; n < 2; ++n) _Pragma("unroll") for (int k = 0; k < 2; ++k) dst[n][k] = *(const PG8_LAS bf16x8*)(lds + PG8_SB(b, h) + boff + n * 2048 + k * 1024); } while (0)
#define PG8_MMA(ai, bj, At, Bt) do { __builtin_amdgcn_s_setprio(1); _Pragma("unroll") for (int m = 0; m < 4; ++m) _Pragma("unroll") for (int n = 0; n < 2; ++n) _Pragma("unroll") for (int k = 0; k < 2; ++k) \
        acc[ai][bj][m][n] = __builtin_amdgcn_mfma_f32_16x16x32_bf16(Bt[n][k], At[m][k], acc[ai][bj][m][n], 0, 0, 0); __builtin_amdgcn_s_setprio(0); } while (0)
#define PG8_WAIT_V(n) asm volatile("s_waitcnt vmcnt(" #n ")" ::: "memory")
#define PG8_WAIT_L(n) asm volatile("s_waitcnt lgkmcnt(" #n ")" ::: "memory")
#define PG8_BAR __builtin_amdgcn_s_barrier()
#define PG8_SCHED __builtin_amdgcn_sched_barrier(0)
#define PG8_AT(base, tt) ((base) + (size_t)(tt) * kstep + ((tt) >= tsplit ? adelta : 0))
    Unit cur, nxt; int ui = 0;
    if (!S.next(0, cur)) return;
    f32x4 acc[2][2][4][2];
#pragma unroll
    for (int a = 0; a < 2; ++a)
#pragma unroll
        for (int b = 0; b < 2; ++b)
#pragma unroll
            for (int m = 0; m < 4; ++m)
#pragma unroll
                for (int n = 0; n < 2; ++n) acc[a][b][m][n] = (f32x4){0.f, 0.f, 0.f, 0.f};
    bf16x8 At[4][2], B0[2][2], B1[2][2];
    const char* cA = (const char*)g.A + (size_t)cur.pm * tstepA; const char* cB = (const char*)g.Bt + (size_t)cur.pn * tstepB;
    PG8_STAGE(PG8_SB(0, 0), cB, voffB); PG8_STAGE(PG8_SB(0, 1), cB + hstepB, voffB); PG8_STAGE(PG8_SA(0, 0), cA, voffA); PG8_STAGE(PG8_SA(0, 1), cA + hstepA, voffA);
    if (wr == 1) PG8_BAR;
    PG8_WAIT_V(2); PG8_BAR;
    PG8_STAGE(PG8_SB(1, 0), cB + kstep, voffB); PG8_STAGE(PG8_SA(1, 0), cA + kstep, voffA); PG8_STAGE(PG8_SB(1, 1), cB + hstepB + kstep, voffB);
    PG8_WAIT_V(6); PG8_BAR;
    for (;;) {
        const bool has_next = S.next(ui + 1, nxt);
        const char* nA = has_next ? (const char*)g.A + (size_t)nxt.pm * tstepA : cA; const char* nB = has_next ? (const char*)g.Bt + (size_t)nxt.pn * tstepB : cB;
        for (int seg = 0; seg < (Epi::HAS_MID ? 2 : 1); ++seg) {
        const int t_lo = (Epi::HAS_MID && seg == 1) ? tsplit : 0, t_hi = (Epi::HAS_MID && seg == 0) ? tsplit : nt;
        if constexpr (Epi::HAS_MID) { if (seg == 1) E.mid(acc, cur, wr, wc, fr, fq); }
        for (int t = t_lo; t < t_hi; t += 2) {
            const bool last = (t == nt - 2);
            const char* a1 = PG8_AT(cA, t + 1);
            const char* a2 = last ? nA : PG8_AT(cA, t + 2); const char* b2 = last ? nB : cB + (size_t)(t + 2) * kstep;
            const char* a3 = a2 + kstep; const char* b3 = b2 + kstep;
            PG8_LDB(B0, 0, 0); PG8_LDB(B1, 0, 1); PG8_SCHED; PG8_LDA(At, 0, 0); PG8_STAGE(PG8_SA(1, 1), a1 + hstepA, voffA);
            PG8_WAIT_V(8); PG8_WAIT_L(0); PG8_BAR; PG8_MMA(0, 0, At, B0); PG8_MMA(0, 1, At, B1); PG8_BAR; PG8_SCHED;
            PG8_LDA(At, 0, 1); PG8_STAGE(PG8_SB(0, 0), b2, voffB); PG8_STAGE(PG8_SB(0, 1), b2 + hstepB, voffB); PG8_STAGE(PG8_SA(0, 0), a2, voffA);
            PG8_WAIT_V(8); PG8_WAIT_L(0); PG8_BAR; PG8_MMA(1, 0, At, B0); PG8_MMA(1, 1, At, B1); PG8_BAR; PG8_SCHED;
            PG8_LDB(B0, 1, 0); PG8_LDB(B1, 1, 1); PG8_SCHED; PG8_LDA(At, 1, 0); PG8_STAGE(PG8_SA(0, 1), a2 + hstepA, voffA);
            PG8_WAIT_V(8); PG8_WAIT_L(0); PG8_BAR; PG8_MMA(0, 0, At, B0); PG8_MMA(0, 1, At, B1); PG8_BAR; PG8_SCHED;
            PG8_LDA(At, 1, 1); PG8_STAGE(PG8_SB(1, 0), b3, voffB); PG8_STAGE(PG8_SB(1, 1), b3 + hstepB, voffB); PG8_STAGE(PG8_SA(1, 0), a3, voffA);
            PG8_WAIT_V(8); PG8_WAIT_L(0); PG8_BAR; PG8_MMA(1, 0, At, B0); PG8_MMA(1, 1, At, B1); PG8_BAR; PG8_SCHED;
        }
        }
        if constexpr (ALIGN_EPI) { if (wr == 0) PG8_BAR; }
        if (!g.noepi) E(acc, cur, wr, wc, fr, fq);
        if (!has_next) break;
#pragma unroll
        for (int a = 0; a < 2; ++a)
#pragma unroll
            for (int b = 0; b < 2; ++b)
#pragma unroll
                for (int m = 0; m < 4; ++m)
#pragma unroll
                    for (int n = 0; n < 2; ++n) acc[a][b][m][n] = (f32x4){0.f, 0.f, 0.f, 0.f};
        cur = nxt; cA = nA; cB = nB; ++ui;
        if constexpr (ALIGN_EPI) { if (wr == 1) PG8_BAR; }
    }
    PG8_WAIT_V(0);
    if constexpr (!ALIGN_EPI) { if (wr == 0) PG8_BAR; }
    PG8_BAR;
#undef PG8_SA
#undef PG8_SB
#undef PG8_STAGE
#undef PG8_LDA
#undef PG8_LDB
#undef PG8_MMA
#undef PG8_WAIT_V
#undef PG8_WAIT_L
#undef PG8_BAR
#undef PG8_SCHED
#undef PG8_AT
}

typedef const f32x4 (&AccC)[2][2][4][2];
typedef f32x4 (&AccM)[2][2][4][2];

__device__ __forceinline__ float row_rstd(const float* rstd, int row) { return ((const GAS float*)rstd)[row]; }
struct EpiSwiGLU {
    static constexpr bool PERM = true, HAS_MID = false;
    bf16_t* S; const float* ssq; const float* cb;
    __device__ __forceinline__ void mid(AccM, const Unit&, int, int, int, int) const {}
    __device__ __forceinline__ void operator()(AccC acc, const Unit& u, int wr, int wc, int fr, int fq) const {
        const int row0 = u.pm * BM + wr * 64 + fr, col = u.pn * 128 + wc * 32 + 8 * fq;
        f32x4 ca0 = (f32x4){0.f, 0.f, 0.f, 0.f}, ca1 = ca0, cb0 = ca0, cb1 = ca0;
        if (ssq) { const float* cp = cb + (size_t)((u.pm * BM) >> 11) * (2 * DFF) + u.pn * BM + wc * 32 + 8 * fq;
            ca0 = *(const GAS f32x4*)cp; ca1 = *(const GAS f32x4*)(cp + 4); cb0 = *(const GAS f32x4*)(cp + HALF); cb1 = *(const GAS f32x4*)(cp + HALF + 4); }
        float rsv[8];
#pragma unroll
        for (int r = 0; r < 8; ++r) rsv[r] = ssq ? row_rstd(ssq, row0 + (r >> 2) * HALF + (r & 3) * 16) : 1.0f;
#pragma unroll
        for (int ai = 0; ai < 2; ++ai)
#pragma unroll
            for (int m = 0; m < 4; ++m) {
                const int row = row0 + ai * HALF + m * 16;
                f32x4 a0 = acc[ai][0][m][0], a1 = acc[ai][0][m][1], b0 = acc[ai][1][m][0], b1 = acc[ai][1][m][1];
                if (ssq) { const float rs = rsv[ai * 4 + m]; a0 = a0 * rs + ca0; a1 = a1 * rs + ca1; b0 = b0 * rs + cb0; b1 = b1 * rs + cb1; }
                u32x4 w;
                w.x = pk2(siluf_(a0[0]) * b0[0], siluf_(a0[1]) * b0[1]); w.y = pk2(siluf_(a0[2]) * b0[2], siluf_(a0[3]) * b0[3]);
                w.z = pk2(siluf_(a1[0]) * b1[0], siluf_(a1[1]) * b1[1]); w.w = pk2(siluf_(a1[2]) * b1[2], siluf_(a1[3]) * b1[3]);
                *(GAS u32x4*)(S + (size_t)row * DFF + col) = w;
            }
    }
};
struct EpiResid {
    static constexpr bool PERM = true, HAS_MID = false;
    const float* base; float* out; const float* gate; bf16_t* xs; const float* nw; const float* scm; float* ssq; float scale; int row_base;
    __device__ __forceinline__ void mid(AccM, const Unit&, int, int, int, int) const {}
    __device__ __forceinline__ void operator()(AccC acc, const Unit& u, int wr, int wc, int fr, int fq) const {
        const int rt = row_base + u.pm * BM, b = rt >> 11, lane = fr + 16 * fq;
        const int row0 = rt + wr * 64 + fr, col0 = u.pn * BM + wc * 32 + 8 * fq;
        const float* gp = gate + (size_t)b * INW + col0;
        f32x4 gv[2][2], cs[2][2];
#pragma unroll
        for (int bj = 0; bj < 2; ++bj)
#pragma unroll
            for (int n = 0; n < 2; ++n) { gv[bj][n] = *(const GAS f32x4*)(gp + bj * HALF + n * 4) * scale;
                if (xs) cs[bj][n] = *(const GAS f32x4*)(nw + col0 + bj * HALF + n * 4) * (*(const GAS f32x4*)(scm + (size_t)b * INW + col0 + bj * HALF + n * 4) + 1.0f); }
#pragma unroll
        for (int am = 0; am < 4; ++am) {
            const int ai = am >> 1, m0 = (am & 1) * 2;
            f32x4 bsv[2][2][2];
#pragma unroll
            for (int mm = 0; mm < 2; ++mm) { const size_t off = (size_t)(row0 + ai * HALF + (m0 + mm) * 16) * D + col0;
#pragma unroll
                for (int bj = 0; bj < 2; ++bj)
#pragma unroll
                    for (int n = 0; n < 2; ++n) bsv[mm][bj][n] = *(const GAS f32x4*)(base + off + bj * HALF + n * 4); }
#pragma unroll
            for (int mm = 0; mm < 2; ++mm) { const int m = m0 + mm; const int row = row0 + ai * HALF + m * 16; const size_t off = (size_t)row * D + col0; float sq = 0.f;
#pragma unroll
                for (int bj = 0; bj < 2; ++bj) { f32x4 o[2];
#pragma unroll
                    for (int n = 0; n < 2; ++n) { o[n] = bsv[mm][bj][n] + gv[bj][n] * acc[ai][bj][m][n]; *(GAS f32x4*)(out + off + bj * HALF + n * 4) = o[n];
                        sq += (o[n][0] * o[n][0] + o[n][1] * o[n][1]) + (o[n][2] * o[n][2] + o[n][3] * o[n][3]); }
                    if (xs) { const f32x4 y0 = o[0] * cs[bj][0], y1 = o[1] * cs[bj][1]; u32x4 w; w.x = pk2(y0[0], y0[1]); w.y = pk2(y0[2], y0[3]); w.z = pk2(y1[0], y1[1]); w.w = pk2(y1[2], y1[3]);
                        *(GAS u32x4*)(xs + off + bj * HALF) = w; } }
                if (xs) { sq += shx(sq, 16, lane); sq += shx(sq, 32, lane); if (fq == 0) ((GAS float*)ssq)[(size_t)row * 16 + u.pn * 4 + wc] = sq; } }
            asm volatile("" ::: "memory"); }
    }
};
struct EpiProj {
    static constexpr bool PERM = true, HAS_MID = false;
    bf16_t* P; const float* cosT; const float* sinT; int row_base; const float* ssq; const float* cb;
    __device__ __forceinline__ void mid(AccM, const Unit&, int, int, int, int) const {}
    __device__ __forceinline__ void operator()(AccM acc, const Unit& u, int wr, int wc, int fr, int fq) const {
        const int lrow0 = u.pm * BM + wr * 64 + fr, col = u.pn * BM + wc * 32 + 8 * fq, pn = u.pn;
        { const float* cp = cb + (size_t)((row_base + u.pm * BM) >> 11) * INW + col; f32x4 cv[2][2];
#pragma unroll
            for (int bj = 0; bj < 2; ++bj)
#pragma unroll
                for (int n = 0; n < 2; ++n) cv[bj][n] = *(const GAS f32x4*)(cp + bj * HALF + n * 4);
            float rsv[8];
#pragma unroll
            for (int r = 0; r < 8; ++r) rsv[r] = row_rstd(ssq, row_base + lrow0 + (r >> 2) * HALF + (r & 3) * 16);
#pragma unroll
            for (int ai = 0; ai < 2; ++ai)
#pragma unroll
                for (int m = 0; m < 4; ++m) { const float rs = rsv[ai * 4 + m];
#pragma unroll
                    for (int bj = 0; bj < 2; ++bj)
#pragma unroll
                        for (int n = 0; n < 2; ++n) acc[ai][bj][m][n] = acc[ai][bj][m][n] * rs + cv[bj][n]; } }
        if (pn < 8) {
            const int d0 = wc * 32 + 8 * fq;
#pragma unroll
            for (int ai = 0; ai < 2; ++ai)
#pragma unroll
                for (int m = 0; m < 4; ++m) { const int lrow = lrow0 + ai * HALF + m * 16, pos = (row_base + lrow) & (SEQ - 1);
                    const f32x4 c0 = *(const GAS f32x4*)(cosT + pos * 128 + d0), c1 = *(const GAS f32x4*)(cosT + pos * 128 + d0 + 4);
                    const f32x4 s0 = *(const GAS f32x4*)(sinT + pos * 128 + d0), s1 = *(const GAS f32x4*)(sinT + pos * 128 + d0 + 4);
                    const f32x4 x10 = acc[ai][0][m][0], x11 = acc[ai][0][m][1], x20 = acc[ai][1][m][0], x21 = acc[ai][1][m][1];
                    const f32x4 o10 = x10 * c0 - x20 * s0, o11 = x11 * c1 - x21 * s1, o20 = x10 * s0 + x20 * c0, o21 = x11 * s1 + x21 * c1;
                    u32x4 w1, w2;
                    w1.x = pk2(o10[0], o10[1]); w1.y = pk2(o10[2], o10[3]); w1.z = pk2(o11[0], o11[1]); w1.w = pk2(o11[2], o11[3]);
                    w2.x = pk2(o20[0], o20[1]); w2.y = pk2(o20[2], o20[3]); w2.z = pk2(o21[0], o21[1]); w2.w = pk2(o21[2], o21[3]);
                    bf16_t* rp = P + (size_t)lrow * INW + col; *(GAS u32x4*)rp = w1; *(GAS u32x4*)(rp + HALF) = w2; }
        } else {
            const int act = (pn >= 16 && pn < 24) ? 1 : (pn >= 28 ? 2 : 0);
#pragma unroll
            for (int ai = 0; ai < 2; ++ai)
#pragma unroll
                for (int m = 0; m < 4; ++m) { bf16_t* rp = P + (size_t)(lrow0 + ai * HALF + m * 16) * INW + col;
#pragma unroll
                    for (int bj = 0; bj < 2; ++bj) { f32x4 v0 = acc[ai][bj][m][0], v1 = acc[ai][bj][m][1];
                        if (act == 1) {
#pragma unroll
                            for (int j = 0; j < 4; ++j) { v0[j] = siluf_(v0[j]); v1[j] = siluf_(v1[j]); } }
                        else if (act == 2) {
#pragma unroll
                            for (int j = 0; j < 4; ++j) { v0[j] = sigmoidf_(v0[j]); v1[j] = sigmoidf_(v1[j]); } }
                        u32x4 w; w.x = pk2(v0[0], v0[1]); w.y = pk2(v0[2], v0[3]); w.z = pk2(v1[0], v1[1]); w.w = pk2(v1[2], v1[3]);
                        *(GAS u32x4*)(rp + bj * HALF) = w; } }
        }
    }
};
struct EpiMerged {
    static constexpr bool PERM = true, HAS_MID = true;
    const bf16_t* P; bf16_t* O;
    __device__ __forceinline__ void mid(AccM acc, const Unit& u, int wr, int wc, int fr, int fq) const {
        int lrow0 = u.pm * BM + wr * 64 + fr; const int col = u.pn * BM + wc * 32 + 8 * fq;
        asm volatile("" : "+v"(lrow0));
#pragma unroll
        for (int ai = 0; ai < 2; ++ai)
#pragma unroll
            for (int m = 0; m < 4; ++m) { const bf16_t* rp = P + (size_t)(lrow0 + ai * HALF + m * 16) * INW + col;
#pragma unroll
                for (int bj = 0; bj < 2; ++bj) { const u32x4 sr = *(const GAS u32x4*)(rp + 7168 + bj * HALF), sp = *(const GAS u32x4*)(rp + 8192 + bj * HALF);
#pragma unroll
                    for (int j = 0; j < 4; ++j) { const unsigned a = sr[j], b = sp[j];
                        const float r0 = bf_lo(a) * __builtin_amdgcn_rcpf(bf_lo(b)), r1 = bf_hi(a) * __builtin_amdgcn_rcpf(bf_hi(b));
                        acc[ai][bj][m][j >> 1][(j & 1) * 2] *= r0; acc[ai][bj][m][j >> 1][(j & 1) * 2 + 1] *= r1; } }
                if (m & 1) asm volatile("" ::: "memory"); }
    }
    __device__ __forceinline__ void operator()(AccC acc, const Unit& u, int wr, int wc, int fr, int fq) const {
        const int lrow0 = u.pm * BM + wr * 64 + fr, col = u.pn * BM + wc * 32 + 8 * fq;
#pragma unroll
        for (int ai = 0; ai < 2; ++ai)
#pragma unroll
            for (int m = 0; m < 4; ++m) { const int lrow = lrow0 + ai * HALF + m * 16; const bf16_t* rp = P + (size_t)lrow * INW + col;
#pragma unroll
                for (int bj = 0; bj < 2; ++bj) { const u32x4 sp = *(const GAS u32x4*)(rp + 8192 + bj * HALF);
                    const f32x4 v0 = acc[ai][bj][m][0], v1 = acc[ai][bj][m][1]; u32x4 w;
                    w.x = pk2(v0[0] * bf_lo(sp.x), v0[1] * bf_hi(sp.x)); w.y = pk2(v0[2] * bf_lo(sp.y), v0[3] * bf_hi(sp.y));
                    w.z = pk2(v1[0] * bf_lo(sp.z), v1[1] * bf_hi(sp.z)); w.w = pk2(v1[2] * bf_lo(sp.w), v1[3] * bf_hi(sp.w));
                    *(GAS u32x4*)(O + (size_t)lrow * D + col + bj * HALF) = w; } }
    }
};
}

typedef GAS unsigned gu32;
#define XB_TMO      128
#define XB_XCNT(j)  (256  + 64 * (j))
#define XB_XSUB(j)  (1280 + 64 * (j))
#define XB_XGEN(j)  (2304 + 64 * (j))
#define XB_TOP      3328
#define XB_TOPGEN   3392
#define XCD_BAR_WORDS 3456
#define XB_SPIN_CAP (1u << 18)
__device__ __forceinline__ unsigned xb_ld(unsigned* p)              { return __hip_atomic_load(p, __ATOMIC_RELAXED, __HIP_MEMORY_SCOPE_AGENT); }
__device__ __forceinline__ unsigned xb_add(unsigned* p, unsigned v) { return __hip_atomic_fetch_add(p, v, __ATOMIC_RELAXED, __HIP_MEMORY_SCOPE_AGENT); }
__device__ __forceinline__ unsigned xb_xcc_id() { return (unsigned)__builtin_amdgcn_s_getreg((3 << 11) | 20) & 0xFu; }
#define XB_SPIN(cond, bar) do { unsigned _sp = 0; while (cond) { __builtin_amdgcn_s_sleep(1); \
    if ((++_sp & 255u) == 0u) { if (xb_ld(&(bar)[XB_TMO])) break; if (_sp > XB_SPIN_CAP) { atomicAdd(&(bar)[XB_TMO], 1u); break; } } } } while (0)
struct XcdBarrier { unsigned* bar; unsigned x; volatile LAS unsigned* st; };
__device__ __forceinline__ XcdBarrier xcd_barrier_post(unsigned* bar, volatile LAS unsigned* st) {
    XcdBarrier b; b.bar = bar; b.x = xb_xcc_id(); b.st = st;
    if (threadIdx.x == 0) (void)xb_add(&bar[XB_XCNT(b.x)], 1u);
    return b;
}
__device__ __forceinline__ void xcd_barrier_complete(unsigned* bar, unsigned x, unsigned& nloc, unsigned& nx) {
    const unsigned G = gridDim.x * gridDim.y * gridDim.z;
    unsigned sum, cnt, mine, sp = 0u;
    for (;;) {
        sum = 0u; cnt = 0u; mine = 0u;
#pragma unroll
        for (unsigned j = 0; j < 16; ++j) { const unsigned c = xb_ld(&bar[XB_XCNT(j)]); sum += c; cnt += (c > 0u) ? 1u : 0u; mine = (j == x) ? c : mine; }
        if (sum == G) break;
        __builtin_amdgcn_s_sleep(1);
        if ((++sp & 255u) == 0u) { if (xb_ld(&bar[XB_TMO])) break; if (sp > XB_SPIN_CAP) { atomicAdd(&bar[XB_TMO], 1u); break; } }
    }
    nloc = mine > 0u ? mine : 1u; nx = cnt > 0u ? cnt : 1u;
}
__device__ __forceinline__ void xcd_barrier(const XcdBarrier& b, const int tid) {
    asm volatile("s_waitcnt vmcnt(0)" ::: "memory");
    __syncthreads();
    if (tid == 0) {
        unsigned* bar = b.bar;
        __builtin_amdgcn_s_waitcnt(0);
        unsigned nloc = b.st[0], nx = b.st[1];
        if (nloc == 0u) { xcd_barrier_complete(bar, b.x, nloc, nx); b.st[0] = nloc; b.st[1] = nx; }
        const unsigned old = xb_add(&bar[XB_XSUB(b.x)], 1u);
        const unsigned gen = old / nloc;
        if (old + 1u == (gen + 1u) * nloc) {
            __builtin_amdgcn_fence(__ATOMIC_RELEASE, "agent");
            asm volatile("s_waitcnt vmcnt(0)" ::: "memory");
            const unsigned og = xb_add(&bar[XB_TOP], 1u);
            const unsigned tg = og / nx;
            if (og + 1u == (tg + 1u) * nx) xb_add(&bar[XB_TOPGEN], 1u);
            else XB_SPIN(xb_ld(&bar[XB_TOPGEN]) == tg, bar);
            __builtin_amdgcn_fence(__ATOMIC_ACQUIRE, "agent");
            xb_add(&bar[XB_XGEN(b.x)], 1u);
            asm volatile("s_waitcnt vmcnt(0)" ::: "memory");
        } else {
            XB_SPIN(xb_ld(&bar[XB_XGEN(b.x)]) == gen, bar);
            __builtin_amdgcn_fence(__ATOMIC_ACQUIRE, "agent");
            asm volatile("s_waitcnt vmcnt(0)" ::: "memory");
        }
    }
    __syncthreads();
}

__device__ __forceinline__ void transpose_item(const float* W, int K, int N, bf16* WT, int ldt, int koff, int mode, LAS float* scr, int item, int lane) {
    const int nblk = N / 32, kb = item / nblk, nb = item % nblk, k0 = 64 * kb, n0 = 32 * nb;
#pragma unroll 8
    for (int i = 0; i < 32; ++i) { const int kk = 2 * i + (lane >> 5); scr[kk * 33 + (lane & 31)] = ((const GAS float*)W)[(size_t)(k0 + kk) * N + n0 + (lane & 31)]; }
    LDS_WAIT(); asm volatile("" ::: "memory");
    int drow0 = n0; float sc = 1.f;
    if (mode == 1) { const int half = n0 / DFF, ch = n0 - half * DFF; drow0 = 256 * (ch >> 7) + 128 * half + (ch & 127); }
    if (mode == 2 && n0 >= 1024 && n0 < 2048) sc = 0.0625f;
    const int c = lane & 7;
#pragma unroll
    for (int j = 0; j < 4; ++j) { const int n = (lane >> 3) + 8 * j; const LAS float* s = scr + (8 * c) * 33 + n;
        u32x4 o; o.x = pk2(s[0 * 33] * sc, s[1 * 33] * sc); o.y = pk2(s[2 * 33] * sc, s[3 * 33] * sc); o.z = pk2(s[4 * 33] * sc, s[5 * 33] * sc); o.w = pk2(s[6 * 33] * sc, s[7 * 33] * sc);
        *(GAS u32x4*)(WT + (size_t)(drow0 + n) * ldt + koff + k0 + 8 * c) = o; }
    LDS_WAIT(); asm volatile("" ::: "memory");
}

__device__ __forceinline__ void ada_unit(const float* c, const float* ada_w, float* modp, LAS unsigned char* lds, int au, int tid, int wave, int lane) {
    const int cg = au % 72, kh = au / 72;
    LAS float* scs = (LAS float*)lds;
    LAS float* red = (LAS float*)(lds + 32768);
    for (int idx = tid; idx < 512 * 16; idx += NTHREADS) { const int kk = idx >> 4, b = idx & 15; scs[idx] = siluf_(((const GAS float*)c)[b * D + kh * 512 + kk]); }
    __syncthreads();
    f32x2 acc[16];
#pragma unroll
    for (int b = 0; b < 16; ++b) acc[b] = (f32x2){0.f, 0.f};
    const float* wp = ada_w + (size_t)(kh * 512 + wave * 64) * INW + cg * 128 + 2 * lane;
#pragma unroll 1
    for (int k8 = 0; k8 < 64; k8 += 8) {
        f32x2 w[8];
#pragma unroll
        for (int i = 0; i < 8; ++i) w[i] = *(const GAS f32x2*)(wp + (size_t)(k8 + i) * INW);
#pragma unroll
        for (int i = 0; i < 8; ++i) { const LAS f32x4* sp = (const LAS f32x4*)(scs + (wave * 64 + k8 + i) * 16);
#pragma unroll
            for (int q = 0; q < 4; ++q) { const f32x4 s = sp[q];
                acc[4 * q + 0] += w[i] * s[0]; acc[4 * q + 1] += w[i] * s[1]; acc[4 * q + 2] += w[i] * s[2]; acc[4 * q + 3] += w[i] * s[3]; } }
    }
#pragma unroll
    for (int b = 0; b < 16; ++b) *(LAS f32x2*)(red + (wave * 16 + b) * 128 + 2 * lane) = acc[b];
    __syncthreads();
    for (int o = tid; o < 16 * 128; o += NTHREADS) { float s = 0.f;
#pragma unroll
        for (int w = 0; w < 8; ++w) s += red[w * 2048 + o];
        const int b = o >> 7, col = o & 127; ((GAS float*)modp)[(size_t)kh * (16 * INW) + b * INW + cg * 128 + col] = s; }
    __syncthreads();
}

__device__ __forceinline__ void rope_entry(float* cosT, float* sinT, int idx) {
    const int pos = idx >> 7, i = idx & 127;
    double inv = 1.0, rr = 0.9305720409296989; int e = i;
#pragma unroll
    for (int s = 0; s < 7; ++s) { if (e & 1) inv *= rr; rr *= rr; e >>= 1; }
    const float ang = (float)pos * (float)inv;
    const double a = (double)ang, kq = __builtin_rint(a * 0.6366197723675814), r = __builtin_fma(-kq, 1.5707963267948966, a) - kq * 6.123233995736766e-17, r2 = r * r;
    double sp = -7.647163731819816e-13; sp = sp * r2 + 1.605904383682161e-10; sp = sp * r2 - 2.505210838544172e-08; sp = sp * r2 + 2.755731922398589e-06; sp = sp * r2 - 1.984126984126984e-04; sp = sp * r2 + 8.333333333333333e-03; sp = sp * r2 - 1.666666666666667e-01;
    const double sr = r + r * r2 * sp;
    double cp = 4.779477332387385e-14; cp = cp * r2 - 1.147074559772972e-11; cp = cp * r2 + 2.087675698786810e-09; cp = cp * r2 - 2.755731922398589e-07; cp = cp * r2 + 2.480158730158730e-05; cp = cp * r2 - 1.388888888888889e-03; cp = cp * r2 + 4.166666666666666e-02; cp = cp * r2 - 0.5;
    const double cr = 1.0 + r2 * cp;
    const int qd = ((int)kq) & 3;
    const double sv = (qd == 0) ? sr : (qd == 1) ? cr : (qd == 2) ? -sr : -cr;
    const double cv = (qd == 0) ? cr : (qd == 1) ? -sr : (qd == 2) ? -cr : sr;
    ((GAS float*)cosT)[idx] = (float)cv; ((GAS float*)sinT)[idx] = (float)sv;
}

__device__ __forceinline__ void wc_unit(const float* lin, const float* pscale, const float* wp, float* wcf, int wu, int lane) {
    const int gc0 = (wu >> 1) * 4, n = (wu & 1) * 512 + 8 * lane, g = gc0 >> 8;
    f32x4 acc[4][2];
#pragma unroll
    for (int r = 0; r < 4; ++r) { acc[r][0] = (f32x4){0.f, 0.f, 0.f, 0.f}; acc[r][1] = (f32x4){0.f, 0.f, 0.f, 0.f}; }
#pragma unroll 4
    for (int d = 0; d < 256; ++d) {
        const float* wrow = wp + (size_t)(256 * g + d) * D + n; const f32x4 w0 = *(const GAS f32x4*)wrow, w1 = *(const GAS f32x4*)(wrow + 4);
        const float ps = ((const GAS float*)pscale)[256 * g + d];
#pragma unroll
        for (int r = 0; r < 4; ++r) { const float a = ((const GAS float*)lin)[(size_t)(gc0 + r) * 256 + d] * ps; acc[r][0] += w0 * a; acc[r][1] += w1 * a; }
    }
#pragma unroll
    for (int r = 0; r < 4; ++r) { float* o = wcf + (size_t)(gc0 + r) * D + n; *(GAS f32x4*)o = acc[r][0]; *(GAS f32x4*)(o + 4) = acc[r][1]; }
}

__device__ __forceinline__ void norm_rows(const float* x, const float* nw, const float* modf, const float* modp, const float* ada_b, int shoff, bf16* h, int gw, int NGW, int lane) {
    for (int rb = gw; rb < M / 16; rb += NGW) {
        const int row0 = rb * 16, b = row0 >> 11;
        f32x4 A[4], Bc[4];
#pragma unroll
        for (int j = 0; j < 4; ++j) { const int col = 4 * lane + 256 * j; f32x4 sh, sc;
            if (modp) { const float* p0 = modp + (size_t)b * INW + shoff + col; const float* p1 = p0 + 16 * INW;
                sh = *(const GAS f32x4*)p0 + *(const GAS f32x4*)p1 + *(const GAS f32x4*)(ada_b + shoff + col);
                sc = *(const GAS f32x4*)(p0 + D) + *(const GAS f32x4*)(p1 + D) + *(const GAS f32x4*)(ada_b + shoff + D + col); }
            else { const float* p = modf + (size_t)b * INW + shoff + col; sh = *(const GAS f32x4*)p; sc = *(const GAS f32x4*)(p + D); }
            A[j] = *(const GAS f32x4*)(nw + col) * (sc + 1.0f); Bc[j] = sh; }
#pragma unroll 2
        for (int r = 0; r < 16; ++r) {
            const GAS f32x4* xr = (const GAS f32x4*)(x + (size_t)(row0 + r) * D) + lane;
            f32x4 v[4]; float s = 0.f;
#pragma unroll
            for (int j = 0; j < 4; ++j) { v[j] = xr[64 * j]; s += (v[j].x * v[j].x + v[j].y * v[j].y) + (v[j].z * v[j].z + v[j].w * v[j].w); }
            const float rstd = 1.0f / sqrtf(wave_sum(s, lane) * (1.f / D) + EPS);
            GAS u32x2* o8 = (GAS u32x2*)(h + (size_t)(row0 + r) * D) + lane;
#pragma unroll
            for (int j = 0; j < 4; ++j) { const f32x4 y = v[j] * rstd * A[j] + Bc[j]; u32x2 w; w.x = pk2(y.x, y.y); w.y = pk2(y.z, y.w); o8[64 * j] = w; }
        }
    }
}
__device__ __forceinline__ void final_norm_rows(float* xo, const float* nw, int gw, int NGW, int lane) {
    f32x4 A[4];
#pragma unroll
    for (int j = 0; j < 4; ++j) A[j] = *(const GAS f32x4*)(nw + 4 * lane + 256 * j);
    for (int row = gw; row < M; row += NGW) {
        GAS f32x4* xr = (GAS f32x4*)(xo + (size_t)row * D) + lane;
        f32x4 v[4]; float s = 0.f;
#pragma unroll
        for (int j = 0; j < 4; ++j) { v[j] = xr[64 * j]; s += (v[j].x * v[j].x + v[j].y * v[j].y) + (v[j].z * v[j].z + v[j].w * v[j].w); }
        const float rstd = 1.0f / sqrtf(wave_sum(s, lane) * (1.f / D) + EPS);
#pragma unroll
        for (int j = 0; j < 4; ++j) xr[64 * j] = v[j] * rstd * A[j];
    }
}

namespace ret {
constexpr int KS_STR = 544, VS_STR = 160, ST_STR = 544;
constexpr int KS_OFF = 0, VS_OFF = 128 * KS_STR, ST_OFF = VS_OFF + 128 * VS_STR, END_OFF = ST_OFF + 64 * ST_STR;
static_assert(END_OFF <= 131072, "retention LDS map");
__device__ __forceinline__ s16x4 trd(LAS unsigned char* p) { return __builtin_bit_cast(s16x4, __builtin_amdgcn_ds_read_tr16_b64_v4i16((LAS s16x4*)p)); }
__device__ __forceinline__ bf16x8 cat(s16x4 a, s16x4 b) { return (bf16x8){a[0], a[1], a[2], a[3], b[0], b[1], b[2], b[3]}; }
#define MFMA16(a, b, c) __builtin_amdgcn_mfma_f32_16x16x32_bf16((a), (b), (c), 0, 0, 0)

__device__ __forceinline__ void unit(bf16* P  , f32x2* stats, int uidx, LAS unsigned char* lds, int tid, int wave, int lane) {
    const int es = uidx & 7, bh = uidx >> 3, h = bh & 3, bl = bh >> 2;
    const int r16 = lane & 15, qq = lane >> 4, rho = (lane >> 2) & 3, p4 = lane & 3;
    const int it = (wave < 4) ? wave : 11 - wave;
    const float lg2 = __builtin_amdgcn_logf(1.0f - __builtin_amdgcn_exp2f(-5.0f - (float)h));
    bf16* rowp = P + (size_t)(bl * SEQ) * INW;
    const int qcol = h * 256, kcol = 1024 + h * 256, vcol = 2048 + h * 512 + es * 64;
    { unsigned z0 = 0u; asm volatile("" : "+v"(z0));
      for (int i = tid; i < 64 * ST_STR / 16; i += NTHREADS) *(LAS u32x4*)(lds + ST_OFF + i * 16) = (u32x4){z0, z0, z0, z0}; }
    f32x4 accS[2][4];
#pragma unroll
    for (int a = 0; a < 2; ++a)
#pragma unroll
        for (int e = 0; e < 4; ++e) accS[a][e] = (f32x4){0.f, 0.f, 0.f, 0.f};
    const float g128 = __builtin_amdgcn_exp2f(lg2 * 128.f), gm32 = __builtin_amdgcn_exp2f(lg2 * -32.f), gm128 = __builtin_amdgcn_exp2f(lg2 * -128.f);
    float kdl[8];
#pragma unroll
    for (int jj = 0; jj < 8; ++jj) { const int jl = (jj < 4) ? (4 * qq + jj) : (16 + 4 * qq + jj - 4); kdl[jj] = __builtin_amdgcn_exp2f(lg2 * (float)(127 - jl)); }
    const float gq = __builtin_amdgcn_exp2f(lg2 * (float)(16 * it + r16 + 1));
    u32x4 kst[8], vst[2];
    const unsigned koff0 = (unsigned)(((tid >> 5) * INW + kcol + 8 * (tid & 31)) * 2);
    const unsigned voff0 = (unsigned)(((tid >> 3) * INW + vcol + 8 * (tid & 7)) * 2);
    const unsigned qoff0 = (unsigned)(((16 * it + r16) * INW + qcol + 8 * qq) * 2);
    const int kw_off = KS_OFF + (tid >> 5) * KS_STR + (tid & 31) * 16, vw_off = VS_OFF + (tid >> 3) * VS_STR + (tid & 7) * 16;
    const GAS char* const rowb = (const GAS char*)rowp;
    auto stage_load = [&](int t0) {
        unsigned kb = koff0 + (unsigned)t0 * (INW * 2), vb = voff0 + (unsigned)t0 * (INW * 2);
        asm volatile("" : "+v"(kb), "+v"(vb));
#pragma unroll
        for (int i = 0; i < 8; ++i) kst[i] = *(const GAS u32x4*)(rowb + kb + (unsigned)(16 * i * INW * 2));
#pragma unroll
        for (int i = 0; i < 2; ++i) vst[i] = *(const GAS u32x4*)(rowb + vb + (unsigned)(64 * i * INW * 2));
    };
    auto stage_write = [&]() {
#pragma unroll
        for (int i = 0; i < 8; ++i) *(LAS u32x4*)(lds + kw_off + i * 16 * KS_STR) = kst[i];
#pragma unroll
        for (int i = 0; i < 2; ++i) *(LAS u32x4*)(lds + vw_off + i * 64 * VS_STR) = vst[i];
    };
    bf16x8 qf[8];
    auto q_load = [&](int t0) {
        unsigned qb = qoff0 + (unsigned)t0 * (INW * 2); asm volatile("" : "+v"(qb));
#pragma unroll
        for (int ks = 0; ks < 8; ++ks) qf[ks] = *(const GAS bf16x8*)(rowb + qb + 64 * ks);
    };
    stage_load(0); q_load(0);
    stage_write();
    __syncthreads();
    LAS unsigned char* const ks_row = lds + KS_OFF + r16 * KS_STR + qq * 16;
    LAS unsigned char* const st_row = lds + ST_OFF + r16 * ST_STR + qq * 16;
    LAS unsigned char* const v_tr = lds + VS_OFF + (4 * qq + rho) * VS_STR + p4 * 8;
    LAS unsigned char* const k_tr = lds + KS_OFF + (4 * qq + rho) * KS_STR + (32 * wave) * 2 + p4 * 8;
#pragma unroll 1
    for (int c = 0; c < 16; ++c) {
        const int t0 = c * 128;
#define RT_LD4(dst, base, k0) do { _Pragma("unroll") for (int k_ = 0; k_ < 4; ++k_) dst[k_] = *(const LAS bf16x8*)((base) + ((k0) + k_) * 64); } while (0)
#define RT_MM4(accv, fr, k0) do { _Pragma("unroll") for (int k_ = 0; k_ < 4; ++k_) accv = MFMA16(fr[k_], qf[(k0) + k_], accv); } while (0)
#define RT_FENCE() asm volatile("" ::: "memory")
        f32x4 ax[4]; bf16x8 fa[4], fb[4];
#pragma unroll
        for (int et = 0; et < 4; ++et) ax[et] = (f32x4){0.f, 0.f, 0.f, 0.f};
        RT_LD4(fa, st_row, 0); RT_LD4(fb, st_row, 4); RT_FENCE();
#pragma unroll
        for (int et = 0; et < 4; ++et) {
            RT_MM4(ax[et], fa, 0); if (et < 3) RT_LD4(fa, st_row + (et + 1) * 16 * ST_STR, 0); RT_FENCE();
            RT_MM4(ax[et], fb, 4); if (et < 3) RT_LD4(fb, st_row + (et + 1) * 16 * ST_STR, 4); RT_FENCE();
        }
        {
            float gsp = gm128;
#pragma unroll 1
            for (int s = 0; s < 4; ++s) {
                if (2 * s <= it) {
                    f32x4 s0 = (f32x4){0.f, 0.f, 0.f, 0.f}, s1 = (f32x4){0.f, 0.f, 0.f, 0.f};
                    const bool t1 = (2 * s + 1 <= it);
                    bf16x8 ga[4], gb[4];
                    RT_LD4(ga, ks_row + (2 * s) * 16 * KS_STR, 0); RT_LD4(gb, ks_row + (2 * s) * 16 * KS_STR, 4); RT_FENCE();
                    RT_MM4(s0, ga, 0); if (t1) RT_LD4(ga, ks_row + (2 * s + 1) * 16 * KS_STR, 0); RT_FENCE();
                    RT_MM4(s0, gb, 4); if (t1) RT_LD4(gb, ks_row + (2 * s + 1) * 16 * KS_STR, 4); RT_FENCE();
                    if (t1) { RT_MM4(s1, ga, 0); RT_MM4(s1, gb, 4); }
                    s16x4 vlo[4], vhi[4];
#pragma unroll
                    for (int et = 0; et < 4; ++et) { vlo[et] = trd(v_tr + s * 32 * VS_STR + et * 32); vhi[et] = trd(v_tr + s * 32 * VS_STR + 16 * VS_STR + et * 32); }
#pragma unroll
                    for (int reg = 0; reg < 4; ++reg) { s0[reg] *= kdl[reg] * gsp; s1[reg] *= kdl[4 + reg] * gsp; }
                    if (2 * s == it) {
#pragma unroll
                        for (int reg = 0; reg < 4; ++reg) s0[reg] = (4 * qq + reg <= r16) ? s0[reg] : 0.f;
                    }
                    if (2 * s + 1 == it) {
#pragma unroll
                        for (int reg = 0; reg < 4; ++reg) s1[reg] = (4 * qq + reg <= r16) ? s1[reg] : 0.f;
                    }
                    u32x4 pw; pw.x = pk2(s0[0], s0[1]); pw.y = pk2(s0[2], s0[3]); pw.z = pk2(s1[0], s1[1]); pw.w = pk2(s1[2], s1[3]);
                    const bf16x8 pf = __builtin_bit_cast(bf16x8, pw);
#pragma unroll
                    for (int et = 0; et < 4; ++et) ax[et] = MFMA16(cat(vlo[et], vhi[et]), pf, ax[et]);
                    RT_FENCE();
                }
                gsp *= gm32;
            }
        }
        {
            float s1 = 0.f, s2 = 0.f; const size_t lrow = (size_t)(bl * SEQ + t0 + 16 * it + r16);
            bf16* op = P + lrow * INW + vcol + 4 * qq;
#pragma unroll
            for (int et = 0; et < 4; ++et) { const f32x4 o = ax[et] * gq;
                s1 += (o[0] + o[1]) + (o[2] + o[3]); s2 += (o[0] * o[0] + o[1] * o[1]) + (o[2] * o[2] + o[3] * o[3]);
                u32x2 w; w.x = pk2(o[0], o[1]); w.y = pk2(o[2], o[3]); *(GAS u32x2*)(op + 16 * et) = w; }
            s1 += shx(s1, 16, lane); s1 += shx(s1, 32, lane); s2 += shx(s2, 16, lane); s2 += shx(s2, 32, lane);
            if (qq == 0) ((GAS f32x2*)stats)[(lrow * 4 + h) * 8 + es] = (f32x2){s1, s2};
        }
        asm volatile("" ::: "memory");
        if (c + 1 < 16) { q_load(t0 + 128); stage_load(t0 + 128); }
#pragma unroll
        for (int a = 0; a < 2; ++a)
#pragma unroll
            for (int e = 0; e < 4; ++e) accS[a][e] *= g128;
        {
            float gs = 1.0f;
#pragma unroll
            for (int s = 0; s < 4; ++s) {
                s16x4 kA[4], vA[4];
#pragma unroll
                for (int d_ = 0; d_ < 2; ++d_) { kA[2 * d_] = trd(k_tr + s * 32 * KS_STR + d_ * 32); kA[2 * d_ + 1] = trd(k_tr + s * 32 * KS_STR + 16 * KS_STR + d_ * 32); }
#pragma unroll
                for (int e_ = 0; e_ < 2; ++e_) { vA[2 * e_] = trd(v_tr + s * 32 * VS_STR + e_ * 32); vA[2 * e_ + 1] = trd(v_tr + s * 32 * VS_STR + 16 * VS_STR + e_ * 32); }
                RT_FENCE();
                bf16x8 kf_[2];
#pragma unroll
                for (int d_ = 0; d_ < 2; ++d_) { const u32x4 raw_ = __builtin_bit_cast(u32x4, cat(kA[2 * d_], kA[2 * d_ + 1])); u32x4 sc_;
#pragma unroll
                    for (int j_ = 0; j_ < 4; ++j_) sc_[j_] = pk2(bf_lo(raw_[j_]) * (kdl[2 * j_] * gs), bf_hi(raw_[j_]) * (kdl[2 * j_ + 1] * gs));
                    kf_[d_] = __builtin_bit_cast(bf16x8, sc_); }
#pragma unroll
                for (int e_ = 0; e_ < 2; ++e_) { const bf16x8 vf_ = cat(vA[2 * e_], vA[2 * e_ + 1]); accS[0][e_] = MFMA16(kf_[0], vf_, accS[0][e_]); accS[1][e_] = MFMA16(kf_[1], vf_, accS[1][e_]); }
#pragma unroll
                for (int e_ = 0; e_ < 2; ++e_) { vA[2 * e_] = trd(v_tr + s * 32 * VS_STR + (e_ + 2) * 32); vA[2 * e_ + 1] = trd(v_tr + s * 32 * VS_STR + 16 * VS_STR + (e_ + 2) * 32); }
                RT_FENCE();
#pragma unroll
                for (int e_ = 0; e_ < 2; ++e_) { const bf16x8 vf_ = cat(vA[2 * e_], vA[2 * e_ + 1]); accS[0][e_ + 2] = MFMA16(kf_[0], vf_, accS[0][e_ + 2]); accS[1][e_ + 2] = MFMA16(kf_[1], vf_, accS[1][e_ + 2]); }
                RT_FENCE();
                gs *= gm32;
            }
        }
        __syncthreads();
#pragma unroll
        for (int dkt = 0; dkt < 2; ++dkt)
#pragma unroll
            for (int et = 0; et < 4; ++et) { const f32x4 v = accS[dkt][et]; u32x2 w; w.x = pk2(v[0], v[1]); w.y = pk2(v[2], v[3]);
                *(LAS u32x2*)(lds + ST_OFF + (16 * et + r16) * ST_STR + (32 * wave + 16 * dkt + 4 * qq) * 2) = w; }
        if (c + 1 < 16) stage_write();
        __syncthreads();
    }
}
}

constexpr int SHL_STR = 1032;
__device__ __forceinline__ void cbias_tiles(const bf16* WT, int N, float* cb, const LAS bf16* sh_hi, const LAS bf16* sh_lo, int gw, int NGW, int lane) {
    const int r16 = lane & 15, qq = lane >> 4;
    for (int tile = gw; tile < N / 16; tile += NGW) {
        const bf16* wp = WT + (size_t)(tile * 16 + r16) * D + 8 * qq;
        f32x4 acc = (f32x4){0.f, 0.f, 0.f, 0.f};
#pragma unroll 8
        for (int ks = 0; ks < 32; ++ks) {
            const bf16x8 bfrag = *(const GAS bf16x8*)(wp + 32 * ks);
            const bf16x8 ah = *(const LAS bf16x8*)(sh_hi + r16 * SHL_STR + 32 * ks + 8 * qq), al = *(const LAS bf16x8*)(sh_lo + r16 * SHL_STR + 32 * ks + 8 * qq);
            acc = __builtin_amdgcn_mfma_f32_16x16x32_bf16(ah, bfrag, acc, 0, 0, 0); acc = __builtin_amdgcn_mfma_f32_16x16x32_bf16(al, bfrag, acc, 0, 0, 0);
        }
#pragma unroll
        for (int reg = 0; reg < 4; ++reg) ((GAS float*)cb)[(size_t)(4 * qq + reg) * N + tile * 16 + r16] = acc[reg];
    }
}
__device__ __forceinline__ void gn_rows(bf16* P, const f32x2* stats, const float* gnw, int gw, int NGW, int lane) {
    const int hh = lane >> 4;
    f32x4 wv[8];
#pragma unroll
    for (int j = 0; j < 8; ++j) wv[j] = *(const GAS f32x4*)(gnw + 32 * lane + 4 * j);
    for (int row = gw; row < MH; row += 2 * NGW) {
        const int rowB = (row + NGW < MH) ? row + NGW : row;
        u32x4 raw[2][4], gg[2][4]; f32x4 st[2][4];
#pragma unroll
        for (int t = 0; t < 2; ++t) { const int r = t ? rowB : row; const bf16* rp = P + (size_t)r * INW + 32 * lane;
            const GAS f32x4* sp = (const GAS f32x4*)(stats + ((size_t)r * 4 + hh) * 8);
#pragma unroll
            for (int j = 0; j < 4; ++j) { raw[t][j] = *(const GAS u32x4*)(rp + 2048 + 8 * j); gg[t][j] = *(const GAS u32x4*)(rp + 4096 + 8 * j); st[t][j] = sp[j]; } }
#pragma unroll
        for (int t = 0; t < 2; ++t) { const int r = t ? rowB : row; bf16* rp = P + (size_t)r * INW + 32 * lane;
            float s1 = 0.f, s2 = 0.f;
#pragma unroll
            for (int j = 0; j < 4; ++j) { s1 += st[t][j].x + st[t][j].z; s2 += st[t][j].y + st[t][j].w; }
            const float mu = s1 * (1.f / 512.f), var = fmaxf(s2 * (1.f / 512.f) - mu * mu, 0.f), rstd = 1.0f / sqrtf(var + EPS);
            if (t == 0 || rowB != row) {
#pragma unroll
                for (int j = 0; j < 4; ++j) { u32x4 o;
#pragma unroll
                    for (int k = 0; k < 4; ++k) { const f32x4 w4 = wv[2 * j + (k >> 1)];
                        const float y0 = bf_lo(gg[t][j][k]) * (bf_lo(raw[t][j][k]) - mu) * rstd * w4[(k & 1) * 2], y1 = bf_hi(gg[t][j][k]) * (bf_hi(raw[t][j][k]) - mu) * rstd * w4[(k & 1) * 2 + 1];
                        o[k] = pk2(y0, y1); }
                    *(GAS u32x4*)(rp + 4096 + 8 * j) = o; } }
        }
    }
}
template <int W>
__device__ __forceinline__ void pool_block(bf16* P, int row0, int col) {
    const int pos0 = row0 & (SEQ - 1);
    const bf16* up = P + (size_t)row0 * INW + 6144 + col;
    u32x2 v[16 + W - 1];
#pragma unroll
    for (int i = 0; i < 16 + W - 1; ++i) { const int dr = i - (W - 1); v[i] = (u32x2){0u, 0u}; if (dr >= 0 || pos0 > 0) v[i] = *(const GAS u32x2*)(up + (ptrdiff_t)dr * INW); }
    float s0 = 0.f, s1 = 0.f, s2 = 0.f, s3 = 0.f;
#pragma unroll
    for (int i = 0; i < W - 1; ++i) { s0 += bf_lo(v[i].x); s1 += bf_hi(v[i].x); s2 += bf_lo(v[i].y); s3 += bf_hi(v[i].y); }
#pragma unroll
    for (int r = 0; r < 16; ++r) {
        const u32x2 c = v[r + W - 1];
        s0 += bf_lo(c.x); s1 += bf_hi(c.x); s2 += bf_lo(c.y); s3 += bf_hi(c.y);
        const int pos = pos0 + r; const float inv = 1.0f / (float)(pos + 1 < W ? pos + 1 : W);
        u32x2 o; o.x = pk2(s0 * inv - bf_lo(c.x), s1 * inv - bf_hi(c.x)); o.y = pk2(s2 * inv - bf_lo(c.y), s3 * inv - bf_hi(c.y));
        *(GAS u32x2*)(P + (size_t)(row0 + r) * INW + col) = o;
        const u32x2 t = v[r]; s0 -= bf_lo(t.x); s1 -= bf_hi(t.x); s2 -= bf_lo(t.y); s3 -= bf_hi(t.y);
    }
}
__device__ __forceinline__ void pool_units(bf16* P, int gw, int NGW, int lane) {
    for (int wu = gw; wu < (MH / 16) * 4; wu += NGW) {
        const int rb = wu >> 2, g = wu & 3, col = g * 256 + 4 * lane, row0 = rb * 16;
        if (g == 0) pool_block<2>(P, row0, col); else if (g == 1) pool_block<4>(P, row0, col); else if (g == 2) pool_block<8>(P, row0, col); else pool_block<16>(P, row0, col);
    }
}

struct Args { const float* in[19]; float* out; unsigned char* ws; int ph_lo, ph_hi; };
__device__ __forceinline__ const float* in_ptr(const Args& a, int i) { asm volatile("" : "+s"(i)); return a.in[i]; }

__global__ void __launch_bounds__(NTHREADS, 2) mk_fwd(Args args) {
    extern __shared__ __attribute__((aligned(16))) unsigned char lds_raw[];
    LAS unsigned char* lds = (LAS unsigned char*)lds_raw;
    volatile LAS unsigned* MISC = (volatile LAS unsigned*)(lds + MISC_OFF);
    const int G = gridDim.x; const int bx = blockIdx.x;
    const int wave0 = __builtin_amdgcn_readfirstlane(threadIdx.x >> 6);
    {
        unsigned* ctl0 = (unsigned*)(args.ws + WS_CTL);
        for (int u = threadIdx.x; u < (LDS_BYTES - 131072) / 4; u += NTHREADS) ((LAS unsigned*)(lds + 131072))[u] = 0u;
        __syncthreads();
    }
    XcdBarrier bar = xcd_barrier_post((unsigned*)(args.ws + WS_CTL) + CW_BAR, MISC + 8);

#define PHASE_PREAMBLE() \
        int wave = wave0; asm volatile("" : "+s"(wave)); \
        int lane; asm volatile("v_mbcnt_lo_u32_b32 %0, -1, 0\n\tv_mbcnt_hi_u32_b32 %0, -1, %0" : "=v"(lane)); \
        const int tid = wave * 64 + lane; \
        unsigned char* ws = args.ws; asm volatile("" : "+s"(ws)); \
        const int vcu = (G % 8 == 0) ? (bx % 8) * (G / 8) + bx / 8 : bx; \
        const int gw = vcu * NWAVES + wave, NGW = G * NWAVES; \
        const float* x = in_ptr(args, 0); float* out = args.out; \
        float* modp = (float*)(ws + WS_MODP); float* modf = (float*)(ws + WS_MODF); \
        float* cosT = (float*)(ws + WS_COS); float* sinT = (float*)(ws + WS_SIN); \
        float* wcf = (float*)(ws + WS_WCF); f32x2* stats = (f32x2*)(ws + WS_STATS); \
        bf16* w13t1 = (bf16*)(ws + WS_W13T1); bf16* w13t2 = (bf16*)(ws + WS_W13T2); bf16* w2t1 = (bf16*)(ws + WS_W2T1); bf16* w2t2 = (bf16*)(ws + WS_W2T2); \
        bf16* wint = (bf16*)(ws + WS_WINT); bf16* bcat = (bf16*)(ws + WS_BCAT); bf16* woutt = (bf16*)(ws + WS_WOUT); \
        bf16* H = (bf16*)(ws + WS_H); bf16* BIG = (bf16*)(ws + WS_BIG); bf16* MERGED = (bf16*)(ws + WS_MERGED); \
        float* ssq = (float*)(ws + WS_SSQ); float* rstd = (float*)(ws + WS_RSTD); float* cbin = (float*)(ws + WS_CBIN); float* cbup = (float*)(ws + WS_CBUP);
    if (args.ph_lo == 0) {
        PHASE_PREAMBLE()
            if (vcu < 144) ada_unit(in_ptr(args, 1), in_ptr(args, 2), modp, lds, vcu, tid, wave, lane);
            for (int idx = gw * 64 + lane; idx < SEQ * 128; idx += NGW * 64) rope_entry(cosT, sinT, idx);
            for (int wu = gw; wu < 512; wu += NGW) wc_unit(in_ptr(args, 11), in_ptr(args, 12), in_ptr(args, 13), wcf, wu, lane);
            LAS float* scr = (LAS float*)(lds + wave * 16384);
            constexpr int I13 = (D / 64) * (2 * DFF / 32), I2 = (DFF / 64) * (D / 32), IIN = (D / 64) * (INW / 32), IR = (2048 / 64) * (D / 32), IO = (D / 64) * (D / 32);
            constexpr int NITEMS = 2 * I13 + 2 * I2 + IIN + IR + IO;
            for (int it = gw; it < NITEMS; it += NGW) {
                int r = it;
                if (r < I13) { transpose_item(in_ptr(args, 5), D, 2 * DFF, w13t1, D, 0, 1, scr, r, lane); continue; } r -= I13;
                if (r < I2) { transpose_item(in_ptr(args, 6), DFF, D, w2t1, DFF, 0, 0, scr, r, lane); continue; } r -= I2;
                if (r < IIN) { transpose_item(in_ptr(args, 8), D, INW, wint, D, 0, 2, scr, r, lane); continue; } r -= IIN;
                if (r < IR) { transpose_item(in_ptr(args, 10), 2048, D, bcat, 3072, 0, 0, scr, r, lane); continue; } r -= IR;
                if (r < IO) { transpose_item(in_ptr(args, 14), D, D, woutt, D, 0, 0, scr, r, lane); continue; } r -= IO;
                if (r < I13) { transpose_item(in_ptr(args, 16), D, 2 * DFF, w13t2, D, 0, 1, scr, r, lane); continue; } r -= I13;
                transpose_item(in_ptr(args, 17), DFF, D, w2t2, DFF, 0, 0, scr, r, lane);
            }
        if (args.ph_hi > 1) xcd_barrier(bar, tid);
    }
    constexpr int REP = REPEAT_PH, RLEN = REPEAT_LEN;
    const int i_hi = args.ph_hi + ((REP > 0 && args.ph_lo <= REP && REP < args.ph_hi) ? RLEN : 0);
    for (int i = (args.ph_lo > 1 ? args.ph_lo : 1); i < i_hi; ++i) {
        const int ph = (REP > 0 && i > REP + RLEN - 1) ? i - RLEN : i;
        PHASE_PREAMBLE()
        if (ph == 1) {
            for (int idx = (gw * 64 + lane) * 4; idx < 16 * INW; idx += NGW * 64 * 4)
                *(GAS f32x4*)(modf + idx) = *(const GAS f32x4*)(modp + idx) + *(const GAS f32x4*)(modp + 16 * INW + idx) + *(const GAS f32x4*)(in_ptr(args, 3) + (idx % INW));
            LAS float* scr = (LAS float*)(lds + wave * 16384);
            for (int it = gw; it < (D / 64) * (D / 32); it += NGW) transpose_item(wcf, D, D, bcat, 3072, 2048, 0, scr, it, lane);
            __syncthreads();
            { LAS bf16* shl = (LAS bf16*)lds; const float* ab = in_ptr(args, 3);
#pragma unroll 1
                for (int set = 0; set < 2; ++set) {
                    for (int idx = tid * 4; idx < 16 * D; idx += NTHREADS * 4) { const int bb = idx >> 10, k = idx & 1023; const size_t o = (size_t)bb * INW + (set ? 6 * D : 3 * D) + k;
                        const f32x4 v = *(const GAS f32x4*)(modp + o) + *(const GAS f32x4*)(modp + 16 * INW + o) + *(const GAS f32x4*)(ab + (set ? 6 * D : 3 * D) + k);
                        u32x2 hi; hi.x = pk2(v[0], v[1]); hi.y = pk2(v[2], v[3]);
                        u32x2 lo; lo.x = pk2(v[0] - bf_lo(hi.x), v[1] - bf_hi(hi.x)); lo.y = pk2(v[2] - bf_lo(hi.y), v[3] - bf_hi(hi.y));
                        *(LAS u32x2*)(shl + bb * SHL_STR + k) = hi; *(LAS u32x2*)(shl + 16 * SHL_STR + bb * SHL_STR + k) = lo; }
                    __syncthreads();
                    if (set == 0) cbias_tiles(wint, INW, cbin, shl, shl + 16 * SHL_STR, gw, NGW, lane);
                    else cbias_tiles(w13t2, 2 * DFF, cbup, shl, shl + 16 * SHL_STR, gw, NGW, lane);
                    __syncthreads();
                }
            }
            norm_rows(x, in_ptr(args, 4), modf, modp, in_ptr(args, 3), 0, H, gw, NGW, lane);
        } else if (ph == 2 || ph == 16) {
            pg8::Gemm g{H, ph == 2 ? w13t1 : w13t2, D, D, D, 1 << 30, 0};
#if defined(PROBE_NOEPI)
            if (REP > 0 && i == REP) { g.noepi = 1; g.K = PROBE_K; }
#endif
            pg8::StaticOrder S; S.init(M, 2 * DFF, G, bx);
            pg8::EpiSwiGLU E{BIG, ph == 2 ? nullptr : rstd, cbup};
            pg8::gemm_phase<pg8::EpiSwiGLU>(lds, g, S, E, tid);
        } else if (ph == 3 || ph == 17 || ph == 9 || ph == 14) {
            const bool dn = (ph == 3 || ph == 17); const int hb = (ph == 14) ? 1 : 0;
            const bf16* Ap = dn ? BIG : MERGED; const bf16* Bp = (ph == 3) ? w2t1 : (ph == 17) ? w2t2 : woutt; const int Kd = dn ? DFF : D;
            const float* basep = (ph == 3) ? x : out; const float* gatep = modf + ((ph == 3) ? 2 * D : (ph == 17) ? 8 * D : 5 * D);
            bf16* xsp = (ph == 17) ? nullptr : H; const float* nwp = in_ptr(args, (ph == 3) ? 7 : 15); const float* scp = modf + ((ph == 3) ? 4 * D : 7 * D);
            pg8::Gemm g{Ap, Bp, Kd, Kd, Kd, 1 << 30, 0};
            pg8::StaticOrder S; S.init(dn ? M : MH, D, G, bx);
            pg8::EpiResid E{basep, out, gatep, xsp, nwp, scp, ssq, dn ? 0.5f : 1.0f, hb * MH};
            pg8::gemm_phase<pg8::EpiResid>(lds, g, S, E, tid);
        } else if (ph == 4 || ph == 15) {
            for (int row = gw * 64 + lane; row < M; row += NGW * 64) { const GAS f32x4* p = (const GAS f32x4*)(ssq + (size_t)row * 16); const f32x4 a = p[0], b = p[1], c = p[2], d = p[3];
                const float s = ((a[0] + a[1]) + (a[2] + a[3])) + ((b[0] + b[1]) + (b[2] + b[3])) + ((c[0] + c[1]) + (c[2] + c[3])) + ((d[0] + d[1]) + (d[2] + d[3]));
                ((GAS float*)rstd)[row] = 1.0f / sqrtf(s * (1.f / D) + EPS); }
        } else if (ph == 5 || ph == 10) {
            const int hb = (ph == 10);
            pg8::Gemm g{H + (size_t)hb * MH * D, wint, D, D, D, 1 << 30, 0};
            pg8::StaticOrder S; S.init(MH, INW, G, bx);
            pg8::EpiProj E{BIG, cosT, sinT, hb * MH, rstd, cbin};
            pg8::gemm_phase<pg8::EpiProj>(lds, g, S, E, tid);
        } else if (ph == 6 || ph == 11) {
            for (int u = vcu; u < 256; u += G) ret::unit(BIG, stats, u, lds, tid, wave, lane);
        } else if (ph == 7 || ph == 12) {
            gn_rows(BIG, stats, in_ptr(args, 9), gw, NGW, lane);
            pool_units(BIG, gw, NGW, lane);
        } else if (ph == 8 || ph == 13) {
            pg8::Gemm g{BIG + 4096, bcat, INW, 3072, 3072, 32, -(long)(4096 * 2 + 32 * 128)};
            pg8::StaticOrder S; S.init(MH, D, G, bx);
            pg8::EpiMerged E{BIG, MERGED};
            pg8::gemm_phase<pg8::EpiMerged>(lds, g, S, E, tid);
        } else {
            final_norm_rows(out, in_ptr(args, 18), gw, NGW, lane);
        }
        if (i + 1 < i_hi) xcd_barrier(bar, tid);
        if (EXTRA_BARRIERS > 0 && i == 2) { for (int e = 0; e < EXTRA_BARRIERS; ++e) xcd_barrier(bar, tid); }
    }
}

extern "C" void kernel_launch(void* const* d_in, const int* in_sizes, int n_in, void* d_out, int out_size, void* d_ws, size_t ws_size, hipStream_t stream) {
    static int grid = 0;
    if (grid == 0) {
        if (n_in != 19 || in_sizes[0] != M * D || out_size != M * D || ws_size < WS_END) { fprintf(stderr, "kernel_launch: unexpected shapes (n_in %d, in0 %d, out %d, ws %zu)\n", n_in, n_in > 0 ? in_sizes[0] : -1, out_size, ws_size); grid = -1; return; }
        int dev = 0, cus = 0, per_cu = 0;
        if (hipGetDevice(&dev) != hipSuccess || hipDeviceGetAttribute(&cus, hipDeviceAttributeMultiprocessorCount, dev) != hipSuccess) { grid = -1; return; }
        if (hipFuncSetAttribute((const void*)mk_fwd, hipFuncAttributeMaxDynamicSharedMemorySize, LDS_BYTES) != hipSuccess) { fprintf(stderr, "kernel_launch: hipFuncSetAttribute failed\n"); grid = -1; return; }
        if (hipOccupancyMaxActiveBlocksPerMultiprocessor(&per_cu, (const void*)mk_fwd, NTHREADS, LDS_BYTES) != hipSuccess || per_cu < 1) { fprintf(stderr, "kernel_launch: occupancy query says %d blocks per CU\n", per_cu); (void)hipGetLastError(); grid = -1; return; }
        grid = cus;
    }
    if (grid < 0) return;
    (void)hipMemsetAsync((char*)d_ws + WS_CTL, 0, CTL_ZERO_BYTES, stream);
    Args a{};
    for (int i = 0; i < 19; ++i) a.in[i] = (const float*)d_in[i];
    a.out = (float*)d_out; a.ws = (unsigned char*)d_ws;
#if MK_ONE_LAUNCH
    a.ph_lo = 0; a.ph_hi = N_PHASES;
    hipLaunchKernelGGL(mk_fwd, dim3(grid), dim3(NTHREADS), LDS_BYTES, stream, a);
#else
    for (int ph = 0; ph < N_PHASES; ++ph) { a.ph_lo = ph; a.ph_hi = ph + 1; hipLaunchKernelGGL(mk_fwd, dim3(grid), dim3(NTHREADS), LDS_BYTES, stream, a); }
#endif
}
```
